# Optimizing an MI355X kernel written in HIP

```python
import jax, jax.numpy as jnp
from jax import lax
import numpy as np

D_MODEL = 1024
BATCH = 2
SEQ = 8192
DEPTH = 1

CHUNK = 64
RNN_WIDTH = 1024
RNN_HEADS = 8
RNN_HEAD_DIM = RNN_WIDTH // RNN_HEADS
CONV_WIDTH = 4
LRU_C = 8.0
SGU_WIDTH = 1024
SGU_GROUPS = 8
SGU_GROUP_DIM = SGU_WIDTH // SGU_GROUPS
SGU_BLOCK = 2 * CHUNK
D_FF = 3 * D_MODEL
FFN_CONV_WIDTH = 3
N_BRANCHES = 2
N_MOD = 6
EPS = 1e-6
IN_COLS = 2 * RNN_WIDTH + 2 * SGU_WIDTH + N_BRANCHES * D_MODEL

kernel_name = "hybrid_rglru_sgu_convffn_block"


def _rmsnorm(x, g):
    x32 = x.astype(jnp.float32)
    y = x32 * lax.rsqrt(jnp.mean(x32 * x32, axis=-1, keepdims=True) + EPS)
    return (y * g.astype(jnp.float32)).astype(x.dtype)


def _layernorm(x, g, b):
    x32 = x.astype(jnp.float32)
    mu = jnp.mean(x32, axis=-1, keepdims=True)
    var = jnp.mean(jnp.square(x32 - mu), axis=-1, keepdims=True)
    y = (x32 - mu) * lax.rsqrt(var + EPS)
    return (y * g.astype(jnp.float32) + b.astype(jnp.float32)).astype(x.dtype)


def _modulated_norm(x, g, shift, scale):
    return _rmsnorm(x, g) * (1.0 + scale[:, None, :]) + shift[:, None, :]


def _causal_dwconv(x, w, b):
    k_width = w.shape[0]
    seq = x.shape[1]
    xp = jnp.pad(x, ((0, 0), (k_width - 1, 0), (0, 0)))
    y = b + xp[:, 0:seq, :] * w[0]
    for k in range(1, k_width):
        y = y + xp[:, k:k + seq, :] * w[k]
    return y


def _block_diag(x, w, b):
    bsz, seq, _ = x.shape
    xh = x.reshape(bsz, seq, RNN_HEADS, RNN_HEAD_DIM)
    y = jnp.einsum("bshi,hij->bshj", xh, w)
    return y.reshape(bsz, seq, RNN_WIDTH) + b


def _lin_combine(left, right):
    a_l, u_l = left
    a_r, u_r = right
    return a_l * a_r, a_r * u_l + u_r


def _rg_lru(x, w_a, b_a, w_x, b_x, lam):
    r = jax.nn.sigmoid(_block_diag(x, w_a, b_a).astype(jnp.float32))
    i = jax.nn.sigmoid(_block_diag(x, w_x, b_x).astype(jnp.float32))
    log_a = LRU_C * r * jax.nn.log_sigmoid(lam.astype(jnp.float32))
    a = jnp.exp(log_a)
    mult = jnp.sqrt(-jnp.expm1(2.0 * log_a))
    u = mult * (i * x.astype(jnp.float32))
    _, h = lax.associative_scan(_lin_combine, (a, u), axis=1)
    return h.astype(x.dtype)


def _spatial_gating(u, v, ln_g, ln_b, w_s, b_s):
    bsz, seq, _ = v.shape
    n_blk = seq // SGU_BLOCK
    v = _layernorm(v, ln_g, ln_b)
    vb = v.reshape(bsz, n_blk, SGU_BLOCK, SGU_GROUPS, SGU_GROUP_DIM)
    mask = jnp.tril(jnp.ones((SGU_BLOCK, SGU_BLOCK), dtype=w_s.dtype))
    mixed = jnp.einsum("gts,bnsgd->bntgd", w_s * mask, vb)
    mixed = mixed + jnp.transpose(b_s)[None, None, :, :, None]
    return u * mixed.reshape(bsz, seq, SGU_WIDTH)


def setup_inputs(seed: int = 0) -> dict:
    key = jax.random.key(seed)
    ks = jax.random.split(key, 26)

    def nrm(k, shape, scale):
        return jax.random.normal(k, shape, jnp.float32) * scale

    a_c = jax.random.uniform(ks[12], (DEPTH, RNN_WIDTH), jnp.float32, 0.9, 0.999)
    s = a_c ** (1.0 / LRU_C)
    lru_lambda = jnp.log(s) - jnp.log1p(-s)

    return {
        "x": nrm(ks[0], (BATCH, SEQ, D_MODEL), 1.0),
        "c": nrm(ks[1], (BATCH, D_MODEL), 1.0),
        "w_ada": nrm(ks[2], (DEPTH, D_MODEL, N_MOD * D_MODEL), D_MODEL ** -0.5),
        "b_ada": nrm(ks[3], (DEPTH, N_MOD * D_MODEL), 0.02),
        "norm_mix_g": 1.0 + nrm(ks[4], (DEPTH, D_MODEL), 0.05),
        "w_in": nrm(ks[5], (DEPTH, D_MODEL, IN_COLS), D_MODEL ** -0.5),
        "rnn_conv_w": nrm(ks[6], (DEPTH, CONV_WIDTH, RNN_WIDTH), CONV_WIDTH ** -0.5),
        "rnn_conv_b": nrm(ks[7], (DEPTH, RNN_WIDTH), 0.02),
        "lru_w_a": nrm(ks[8], (DEPTH, RNN_HEADS, RNN_HEAD_DIM, RNN_HEAD_DIM), RNN_HEAD_DIM ** -0.5),
        "lru_b_a": nrm(ks[9], (DEPTH, RNN_WIDTH), 0.02),
        "lru_w_x": nrm(ks[10], (DEPTH, RNN_HEADS, RNN_HEAD_DIM, RNN_HEAD_DIM), RNN_HEAD_DIM ** -0.5),
        "lru_b_x": nrm(ks[11], (DEPTH, RNN_WIDTH), 0.02),
        "lru_lambda": lru_lambda,
        "sgu_ln_g": 1.0 + nrm(ks[13], (DEPTH, SGU_WIDTH), 0.05),
        "sgu_ln_b": nrm(ks[14], (DEPTH, SGU_WIDTH), 0.02),
        "sgu_w_s": nrm(ks[15], (DEPTH, SGU_GROUPS, SGU_BLOCK, SGU_BLOCK), SGU_BLOCK ** -0.5),
        "sgu_b_s": 1.0 + nrm(ks[16], (DEPTH, SGU_GROUPS, SGU_BLOCK), 0.1),
        "w_branch_a": nrm(ks[17], (DEPTH, RNN_WIDTH, D_MODEL), RNN_WIDTH ** -0.5),
        "w_branch_b": nrm(ks[18], (DEPTH, SGU_WIDTH, D_MODEL), SGU_WIDTH ** -0.5),
        "w_out": nrm(ks[19], (DEPTH, D_MODEL, D_MODEL), D_MODEL ** -0.5),
        "norm_ffn_g": 1.0 + nrm(ks[20], (DEPTH, D_MODEL), 0.05),
        "w_up": nrm(ks[21], (DEPTH, D_MODEL, 2 * D_FF), D_MODEL ** -0.5),
        "ffn_conv_w": nrm(ks[22], (DEPTH, FFN_CONV_WIDTH, 2 * D_FF), FFN_CONV_WIDTH ** -0.5),
        "ffn_conv_b": nrm(ks[23], (DEPTH, 2 * D_FF), 0.02),
        "w_down": nrm(ks[24], (DEPTH, D_FF, D_MODEL), D_FF ** -0.5),
        "norm_final_g": 1.0 + nrm(ks[25], (D_MODEL,), 0.05),
    }


def reference(x, c, w_ada, b_ada, norm_mix_g, w_in, rnn_conv_w, rnn_conv_b,
              lru_w_a, lru_b_a, lru_w_x, lru_b_x, lru_lambda,
              sgu_ln_g, sgu_ln_b, sgu_w_s, sgu_b_s,
              w_branch_a, w_branch_b, w_out,
              norm_ffn_g, w_up, ffn_conv_w, ffn_conv_b, w_down, norm_final_g):
    split_idx = [RNN_WIDTH, 2 * RNN_WIDTH, 2 * RNN_WIDTH + SGU_WIDTH,
                 2 * RNN_WIDTH + 2 * SGU_WIDTH, 2 * RNN_WIDTH + 2 * SGU_WIDTH + D_MODEL]
    c_act = jax.nn.silu(c)
    for l in range(DEPTH):
        mod = c_act @ w_ada[l] + b_ada[l]
        shift1, scale1, gate1, shift2, scale2, gate2 = jnp.split(mod, N_MOD, axis=-1)

        h = _modulated_norm(x, norm_mix_g[l], shift1, scale1)
        z = h @ w_in[l]
        xr, gr, zu, zv, ga, gb = jnp.split(z, split_idx, axis=-1)

        xr = _causal_dwconv(xr, rnn_conv_w[l], rnn_conv_b[l])
        y_a = _rg_lru(xr, lru_w_a[l], lru_b_a[l], lru_w_x[l], lru_b_x[l], lru_lambda[l])
        y_a = (y_a * jax.nn.gelu(gr)) @ w_branch_a[l]

        y_b = _spatial_gating(jax.nn.gelu(zu), jax.nn.gelu(zv), sgu_ln_g[l], sgu_ln_b[l],
                              sgu_w_s[l], sgu_b_s[l])
        y_b = y_b @ w_branch_b[l]

        merged = jax.nn.sigmoid(ga) * y_a + jax.nn.sigmoid(gb) * y_b
        x = x + gate1[:, None, :] * (merged @ w_out[l])

        h = _modulated_norm(x, norm_ffn_g[l], shift2, scale2)
        hid = _causal_dwconv(h @ w_up[l], ffn_conv_w[l], ffn_conv_b[l])
        act, val = jnp.split(hid, 2, axis=-1)
        x = x + gate2[:, None, :] * ((jax.nn.gelu(act) * val) @ w_down[l])

    return _rmsnorm(x, norm_final_g)
```

```cpp
#include <hip/hip_runtime.h>
#include <cstdio>
#include <cstdint>

typedef unsigned short bf16_t;
constexpr int BATCH = 2, SEQ = 8192, D = 1024, M = BATCH * SEQ, NIN = 6144, DFF = 3072, NUP = 6144;
constexpr size_t MiB = 1u << 20;
constexpr size_t WS_CTL = 0;
constexpr size_t WS_MOD = 64 * 1024;
constexpr size_t WS_STAT = 128 * 1024;
constexpr size_t WS_WIN = 1 * MiB;
constexpr size_t WS_WUP = 13 * MiB;
constexpr size_t WS_WDN = 25 * MiB;
constexpr size_t WS_WA = 31 * MiB, WS_WB = 33 * MiB, WS_WO = 35 * MiB;
constexpr size_t WS_Z = 38 * MiB;
constexpr int LDZ = 6144;
constexpr int ZC_XR = 0, ZC_GR = 1024, ZC_ZU = 2048, ZC_ZV = 3072, ZC_GA = 4096, ZC_GB = 5120;

__device__ __forceinline__ float bf2f(bf16_t v) { return __uint_as_float(((unsigned)v) << 16); }
__device__ __forceinline__ bf16_t f2bf(float f) { unsigned u = __float_as_uint(f); return (bf16_t)((u + 0x7fffu + ((u >> 16) & 1u)) >> 16); }
__device__ __forceinline__ float gelu_t(float x) { const float y = 0.7978845608028654f * (x + 0.044715f * x * x * x); return 0.5f * x * (1.f + tanhf(y)); }
__device__ __forceinline__ float sigm(float x) { return 1.f / (1.f + expf(-x)); }

__global__ void k_transpose(const float* __restrict__ W, bf16_t* __restrict__ WT, int K, int N) {
    __shared__ float t[32][33];
    const int k0 = blockIdx.y * 32, n0 = blockIdx.x * 32, tx = threadIdx.x & 31, ty = threadIdx.x >> 5;
    for (int i = ty; i < 32; i += 8) t[i][tx] = W[(size_t)(k0 + i) * N + n0 + tx];
    __syncthreads();
    for (int i = ty; i < 32; i += 8) WT[(size_t)(n0 + i) * K + k0 + tx] = f2bf(t[tx][i]);
}
__global__ void k_mod(const float* __restrict__ c, const float* __restrict__ w, const float* __restrict__ b, float* __restrict__ mod) {
    const int n = blockIdx.x * blockDim.x + threadIdx.x, bb = blockIdx.y;
    float acc = 0.f;
    for (int k = 0; k < D; ++k) { const float cv = c[bb * D + k]; acc += (cv * sigm(cv)) * w[(size_t)k * 6144 + n]; }
    mod[bb * 6144 + n] = acc + b[n];
}
__global__ void k_modnorm(const float* __restrict__ x, const float* __restrict__ g, const float* __restrict__ mod, int shift_off, int scale_off, bf16_t* __restrict__ out, int ldo) {
    __shared__ float red[256];
    const int m = blockIdx.x, bb = m / SEQ, tid = threadIdx.x;
    float v[4], s = 0.f;
    for (int i = 0; i < 4; ++i) { v[i] = x[(size_t)m * D + tid + 256 * i]; s += v[i] * v[i]; }
    red[tid] = s; __syncthreads();
    for (int o = 128; o > 0; o >>= 1) { if (tid < o) red[tid] += red[tid + o]; __syncthreads(); }
    const float rstd = rsqrtf(red[0] * (1.f / D) + 1e-6f);
    for (int i = 0; i < 4; ++i) { const int cidx = tid + 256 * i; const float y = v[i] * rstd * g[cidx];
        out[(size_t)m * ldo + cidx] = f2bf(y * (1.f + mod[bb * 6144 + scale_off + cidx]) + mod[bb * 6144 + shift_off + cidx]); }
}
__global__ void k_final(float* __restrict__ x, const float* __restrict__ g) {
    __shared__ float red[256];
    const int m = blockIdx.x, tid = threadIdx.x;
    float v[4], s = 0.f;
    for (int i = 0; i < 4; ++i) { v[i] = x[(size_t)m * D + tid + 256 * i]; s += v[i] * v[i]; }
    red[tid] = s; __syncthreads();
    for (int o = 128; o > 0; o >>= 1) { if (tid < o) red[tid] += red[tid + o]; __syncthreads(); }
    const float rstd = rsqrtf(red[0] * (1.f / D) + 1e-6f);
    for (int i = 0; i < 4; ++i) { const int cidx = tid + 256 * i; x[(size_t)m * D + cidx] = v[i] * rstd * g[cidx]; }
}

struct GP { const bf16_t* A; int lda; const bf16_t* Bt; int K; int mode;
            bf16_t* Z; const float* x; float* out; const float* mod; float* tmp; };
enum { MODE_IN = 0, MODE_BRA = 1, MODE_BRB = 2, MODE_OUT = 3, MODE_DOWN = 4 };
__global__ void __launch_bounds__(256) k_gemm(GP p) {
    __shared__ float As[64][33], Bs[64][33];
    const int tid = threadIdx.x, tx = tid & 15, ty = tid >> 4, m0 = blockIdx.y * 64, n0 = blockIdx.x * 64;
    float acc[4][4] = {};
    const int lr = tid >> 2, lk = (tid & 3) * 8;
    for (int k0 = 0; k0 < p.K; k0 += 32) {
        const bf16_t* ap = p.A + (size_t)(m0 + lr) * p.lda + k0 + lk; const bf16_t* bp = p.Bt + (size_t)(n0 + lr) * p.K + k0 + lk;
        for (int i = 0; i < 8; ++i) { As[lr][lk + i] = bf2f(ap[i]); Bs[lr][lk + i] = bf2f(bp[i]); }
        __syncthreads();
        for (int k = 0; k < 32; ++k) { float a[4], b[4];
            for (int i = 0; i < 4; ++i) { a[i] = As[ty * 4 + i][k]; b[i] = Bs[tx * 4 + i][k]; }
            for (int i = 0; i < 4; ++i) for (int j = 0; j < 4; ++j) acc[i][j] += a[i] * b[j]; }
        __syncthreads();
    }
    for (int i = 0; i < 4; ++i) for (int j = 0; j < 4; ++j) {
        const int m = m0 + ty * 4 + i, n = n0 + tx * 4 + j, bb = m / SEQ; const float v = acc[i][j];
        if (p.mode == MODE_IN) { const int reg = n >> 10; float o = v; if (reg >= 1 && reg <= 3) o = gelu_t(v); else if (reg >= 4) o = sigm(v); p.Z[(size_t)m * LDZ + n] = f2bf(o); }
        else if (p.mode == MODE_BRA) { p.tmp[(size_t)m * D + n] = bf2f(p.Z[(size_t)m * LDZ + ZC_GA + n]) * v; }
        else if (p.mode == MODE_BRB) { p.Z[(size_t)m * LDZ + ZC_ZV + n] = f2bf(p.tmp[(size_t)m * D + n] + bf2f(p.Z[(size_t)m * LDZ + ZC_GB + n]) * v); }
        else if (p.mode == MODE_OUT) { p.out[(size_t)m * D + n] = p.x[(size_t)m * D + n] + p.mod[bb * 6144 + 2048 + n] * v; }
        else { p.out[(size_t)m * D + n] = p.out[(size_t)m * D + n] + p.mod[bb * 6144 + 5120 + n] * v; }
    }
}
__global__ void __launch_bounds__(256) k_up(const bf16_t* __restrict__ A, int lda, const bf16_t* __restrict__ Bt, const float* __restrict__ cw, const float* __restrict__ cb, bf16_t* __restrict__ G, int ldg) {
    __shared__ float As[66][33], Bs[64][33];
    const int tid = threadIdx.x, tx = tid & 15, ty = tid >> 4, m0 = blockIdx.y * 64, j0 = blockIdx.x * 32;
    const int t0 = m0 % SEQ;
    float acc[6][4] = {};
    for (int k0 = 0; k0 < D; k0 += 32) {
        for (int e = tid; e < 66 * 32; e += 256) { const int r = e >> 5, k = e & 31; const int tok = t0 - 2 + r;
            As[r][k] = (tok >= 0) ? bf2f(A[(size_t)(m0 - 2 + r) * lda + k0 + k]) : 0.f; }
        for (int e = tid; e < 64 * 32; e += 256) { const int c = e >> 5, k = e & 31; const int col = (c < 32) ? (j0 + c) : (DFF + j0 + c - 32);
            Bs[c][k] = bf2f(Bt[(size_t)col * D + k0 + k]); }
        __syncthreads();
        for (int k = 0; k < 32; ++k) { float a[6], b[4];
            for (int i = 0; i < 6; ++i) a[i] = As[ty * 4 + i][k];
            b[0] = Bs[2 * tx][k]; b[1] = Bs[2 * tx + 1][k]; b[2] = Bs[32 + 2 * tx][k]; b[3] = Bs[32 + 2 * tx + 1][k];
            for (int i = 0; i < 6; ++i) for (int j = 0; j < 4; ++j) acc[i][j] += a[i] * b[j]; }
        __syncthreads();
    }
    for (int i = 0; i < 4; ++i) for (int jj = 0; jj < 2; ++jj) {
        const int j = j0 + 2 * tx + jj, m = m0 + ty * 4 + i;
        const float ua = cb[j] + cw[0 * NUP + j] * acc[i][jj] + cw[1 * NUP + j] * acc[i + 1][jj] + cw[2 * NUP + j] * acc[i + 2][jj];
        const int jv = DFF + j;
        const float uv = cb[jv] + cw[0 * NUP + jv] * acc[i][2 + jj] + cw[1 * NUP + jv] * acc[i + 1][2 + jj] + cw[2 * NUP + jv] * acc[i + 2][2 + jj];
        G[(size_t)m * ldg + j] = f2bf(gelu_t(ua) * uv);
    }
}
__global__ void __launch_bounds__(256) k_rnn(bf16_t* __restrict__ Z, const float* __restrict__ cw, const float* __restrict__ cb, const float* __restrict__ wa, const float* __restrict__ ba,
                                             const float* __restrict__ wx, const float* __restrict__ bx, const float* __restrict__ lam) {
    __shared__ float xc[128]; __shared__ float gi[128];
    const int bb = blockIdx.x >> 3, hd = blockIdx.x & 7, tid = threadIdx.x, j = tid & 127, ch = hd * 128 + j; const bool isx = tid >= 128;
    float w[128];
    const float* wsrc = (isx ? wx : wa) + (size_t)hd * 128 * 128;
#pragma unroll
    for (int i = 0; i < 128; ++i) w[i] = wsrc[i * 128 + j];
    const float bias = isx ? bx[ch] : ba[ch];
    const float lsl = -log1pf(expf(-lam[ch]));
    const float c0 = cw[0 * D + ch], c1 = cw[1 * D + ch], c2 = cw[2 * D + ch], c3 = cw[3 * D + ch], cbias = cb[ch];
    float x3 = 0.f, x2 = 0.f, x1 = 0.f, h = 0.f;
    for (int t = 0; t < SEQ; ++t) {
        const size_t m = (size_t)bb * SEQ + t;
        float xcv = 0.f;
        if (!isx) { const float x0 = bf2f(Z[m * LDZ + ZC_XR + ch]); xcv = cbias + c0 * x3 + c1 * x2 + c2 * x1 + c3 * x0; x3 = x2; x2 = x1; x1 = x0; xc[j] = xcv; }
        __syncthreads();
        float acc = bias;
#pragma unroll
        for (int i = 0; i < 128; ++i) acc += xc[i] * w[i];
        const float gate = sigm(acc);
        if (isx) gi[j] = gate;
        __syncthreads();
        if (!isx) { const float la = 8.f * gate * lsl; const float a = expf(la); const float mult = sqrtf(-expm1f(2.f * la)); const float u = mult * (gi[j] * xcv);
            h = a * h + u; Z[m * LDZ + ZC_GR + ch] = f2bf(h * bf2f(Z[m * LDZ + ZC_GR + ch])); }
    }
}
__global__ void k_lnstat(const bf16_t* __restrict__ Z, float* __restrict__ st) {
    __shared__ float r1[256], r2[256];
    const int m = blockIdx.x, tid = threadIdx.x; float v[4], s = 0.f;
    for (int i = 0; i < 4; ++i) { v[i] = bf2f(Z[(size_t)m * LDZ + ZC_ZV + tid + 256 * i]); s += v[i]; }
    r1[tid] = s; __syncthreads();
    for (int o = 128; o > 0; o >>= 1) { if (tid < o) r1[tid] += r1[tid + o]; __syncthreads(); }
    const float mean = r1[0] * (1.f / D); float q = 0.f;
    for (int i = 0; i < 4; ++i) { const float d = v[i] - mean; q += d * d; }
    r2[tid] = q; __syncthreads();
    for (int o = 128; o > 0; o >>= 1) { if (tid < o) r2[tid] += r2[tid + o]; __syncthreads(); }
    if (tid == 0) { st[2 * m] = mean; st[2 * m + 1] = rsqrtf(r2[0] * (1.f / D) + 1e-6f); }
}
__global__ void __launch_bounds__(256) k_sgu(bf16_t* __restrict__ Z, const float* __restrict__ st, const float* __restrict__ lg, const float* __restrict__ lb, const float* __restrict__ ws_, const float* __restrict__ bs) {
    __shared__ float vn[128][128];
    const int nb = blockIdx.x, g = blockIdx.y, tid = threadIdx.x, d = tid & 127, ch = g * 128 + d; const size_t mb = (size_t)nb * 128;
    for (int s = tid >> 7; s < 128; s += 2) { const size_t m = mb + s; vn[s][d] = (bf2f(Z[m * LDZ + ZC_ZV + ch]) - st[2 * m]) * st[2 * m + 1] * lg[ch] + lb[ch]; }
    __syncthreads();
    for (int t = tid >> 7; t < 128; t += 2) { float acc = 0.f; const float* wr = ws_ + ((size_t)g * 128 + t) * 128;
        for (int s = 0; s <= t; ++s) acc += wr[s] * vn[s][d];
        const size_t m = mb + t; Z[m * LDZ + ZC_ZU + ch] = f2bf(bf2f(Z[m * LDZ + ZC_ZU + ch]) * (acc + bs[g * 128 + t])); }
}

extern "C" void kernel_launch(void* const* d_in, const int* in_sizes, int n_in, void* d_out, int out_size, void* d_ws, size_t ws_size, hipStream_t stream) {
    const float* x = (const float*)d_in[0]; const float* c = (const float*)d_in[1]; const float* w_ada = (const float*)d_in[2]; const float* b_ada = (const float*)d_in[3];
    const float* g_mix = (const float*)d_in[4]; const float* w_in = (const float*)d_in[5]; const float* rcw = (const float*)d_in[6]; const float* rcb = (const float*)d_in[7];
    const float* lwa = (const float*)d_in[8]; const float* lba = (const float*)d_in[9]; const float* lwx = (const float*)d_in[10]; const float* lbx = (const float*)d_in[11];
    const float* lam = (const float*)d_in[12]; const float* slg = (const float*)d_in[13]; const float* slb = (const float*)d_in[14]; const float* sws = (const float*)d_in[15];
    const float* sbs = (const float*)d_in[16]; const float* w_a = (const float*)d_in[17]; const float* w_b = (const float*)d_in[18]; const float* w_o = (const float*)d_in[19];
    const float* g_ffn = (const float*)d_in[20]; const float* w_up = (const float*)d_in[21]; const float* fcw = (const float*)d_in[22]; const float* fcb = (const float*)d_in[23];
    const float* w_dn = (const float*)d_in[24]; const float* g_fin = (const float*)d_in[25];
    unsigned char* ws = (unsigned char*)d_ws; float* out = (float*)d_out;
    float* mod = (float*)(ws + WS_MOD); float* stat = (float*)(ws + WS_STAT);
    bf16_t* Win = (bf16_t*)(ws + WS_WIN); bf16_t* Wup = (bf16_t*)(ws + WS_WUP); bf16_t* Wdn = (bf16_t*)(ws + WS_WDN);
    bf16_t* Wa = (bf16_t*)(ws + WS_WA); bf16_t* Wb = (bf16_t*)(ws + WS_WB); bf16_t* Wo = (bf16_t*)(ws + WS_WO); bf16_t* Z = (bf16_t*)(ws + WS_Z);
    bf16_t* H1 = (bf16_t*)d_out;
    k_transpose<<<dim3(NIN / 32, D / 32), 256, 0, stream>>>(w_in, Win, D, NIN);
    k_transpose<<<dim3(NUP / 32, D / 32), 256, 0, stream>>>(w_up, Wup, D, NUP);
    k_transpose<<<dim3(D / 32, DFF / 32), 256, 0, stream>>>(w_dn, Wdn, DFF, D);
    k_transpose<<<dim3(D / 32, D / 32), 256, 0, stream>>>(w_a, Wa, D, D);
    k_transpose<<<dim3(D / 32, D / 32), 256, 0, stream>>>(w_b, Wb, D, D);
    k_transpose<<<dim3(D / 32, D / 32), 256, 0, stream>>>(w_o, Wo, D, D);
    k_mod<<<dim3(6144 / 256, 2), 256, 0, stream>>>(c, w_ada, b_ada, mod);
    k_modnorm<<<M, 256, 0, stream>>>(x, g_mix, mod, 0, 1024, H1, D);
    { GP p{}; p.A = H1; p.lda = D; p.Bt = Win; p.K = D; p.mode = MODE_IN; p.Z = Z; k_gemm<<<dim3(NIN / 64, M / 64), 256, 0, stream>>>(p); }
    k_rnn<<<16, 256, 0, stream>>>(Z, rcw, rcb, lwa, lba, lwx, lbx, lam);
    k_lnstat<<<M, 256, 0, stream>>>(Z, stat);
    k_sgu<<<dim3(M / 128, 8), 256, 0, stream>>>(Z, stat, slg, slb, sws, sbs);
    { GP p{}; p.A = Z + ZC_GR; p.lda = LDZ; p.Bt = Wa; p.K = D; p.mode = MODE_BRA; p.Z = Z; p.tmp = out; k_gemm<<<dim3(D / 64, M / 64), 256, 0, stream>>>(p); }
    { GP p{}; p.A = Z + ZC_ZU; p.lda = LDZ; p.Bt = Wb; p.K = D; p.mode = MODE_BRB; p.Z = Z; p.tmp = out; k_gemm<<<dim3(D / 64, M / 64), 256, 0, stream>>>(p); }
    { GP p{}; p.A = Z + ZC_ZV; p.lda = LDZ; p.Bt = Wo; p.K = D; p.mode = MODE_OUT; p.x = x; p.out = out; p.mod = mod; k_gemm<<<dim3(D / 64, M / 64), 256, 0, stream>>>(p); }
    k_modnorm<<<M, 256, 0, stream>>>(out, g_ffn, mod, 3072, 4096, Z + ZC_XR, LDZ);
    k_up<<<dim3(DFF / 32, M / 64), 256, 0, stream>>>(Z + ZC_XR, LDZ, Wup, fcw, fcb, Z + 3072, LDZ);
    { GP p{}; p.A = Z + 3072; p.lda = LDZ; p.Bt = Wdn; p.K = DFF; p.mode = MODE_DOWN; p.out = out; p.mod = mod; k_gemm<<<dim3(D / 64, M / 64), 256, 0, stream>>>(p); }
    k_final<<<M, 256, 0, stream>>>(out, g_fin);
}
```

```cpp
#include <hip/hip_runtime.h>
#include <cstdio>
#include <cstdint>

typedef unsigned short bf16_t;
constexpr int BATCH = 2, SEQ = 8192, D = 1024, M = BATCH * SEQ, NIN = 6144, DFF = 3072, NUP = 6144;
constexpr size_t MiB = 1u << 20;
constexpr size_t WS_CTL = 0, CTL_ZERO_BYTES = 1 * MiB;
constexpr size_t WS_MOD = 64 * 1024;
constexpr size_t WS_STAT = 128 * 1024;
constexpr size_t WS_STAT2 = 256 * 1024;
constexpr size_t WS_WIN = 1 * MiB;
constexpr size_t WS_WUP = 13 * MiB;
constexpr size_t WS_WDN = 25 * MiB;
constexpr size_t WS_WAB = 31 * MiB;
constexpr size_t WS_WO = 35 * MiB;
constexpr size_t WS_LRU = 37 * MiB;
constexpr size_t WS_WM = 37 * MiB + 512 * 1024;
constexpr size_t WS_Z = 38 * MiB;
constexpr size_t WS_SUMM = 230 * MiB;
constexpr size_t WS_HEAD = 231 * MiB, WS_TAIL = 234 * MiB;
constexpr size_t WS_END = 237 * MiB;
constexpr int LDZ = 6144;
constexpr int ZC_XR = 0, ZC_GR = 1024, ZC_ZU = 2048, ZC_ZV = 3072, ZC_GA = 4096, ZC_GB = 5120;
constexpr int CW_BAR = 4096;

__device__ __forceinline__ float bf2f(bf16_t v) { return __uint_as_float(((unsigned)v) << 16); }
__device__ __forceinline__ bf16_t f2bf(float f) { unsigned u = __float_as_uint(f); return (bf16_t)((u + 0x7fffu + ((u >> 16) & 1u)) >> 16); }
__device__ __forceinline__ float gelu_t(float x) { const float y = 0.7978845608028654f * (x + 0.044715f * x * x * x); return 0.5f * x * (1.f + tanhf(y)); }
__device__ __forceinline__ float sigm(float x) { return 1.f / (1.f + expf(-x)); }
__device__ __forceinline__ float gelu_f(float x) { const float p = x * (2.3022082f + 0.10294324f * x * x); return x * __builtin_amdgcn_rcpf(1.f + __builtin_amdgcn_exp2f(-p)); }
__device__ __forceinline__ float sigm_f(float x) { return __builtin_amdgcn_rcpf(1.f + __builtin_amdgcn_exp2f(-1.4426950408889634f * x)); }

namespace pg8 {
#define PG8_LAS __attribute__((address_space(3)))
typedef short bf16x8 __attribute__((ext_vector_type(8)));
typedef float f32x4 __attribute__((ext_vector_type(4)));
typedef unsigned u32x4 __attribute__((ext_vector_type(4)));
constexpr int BM = 256, BK = 64, HALF = 128, HTB = HALF * BK * 2, STAGE_BYTES = 8 * HTB, NXCD = 8, WGM = 8;
__host__ __device__ __forceinline__ int lds_byte(int r, int c) { const int st = (r >> 4) * 2 + (c >> 5), rr = r & 15, cc = c & 31, ob = rr * 64 + cc * 2; return st * 1024 + (ob ^ (((ob >> 9) & 1) << 5)); }
__host__ __device__ __forceinline__ void stage_rc(int b, int& R, int& C) { const int st = b / 1024, sb = b % 1024, swz = sb ^ (((sb >> 9) & 1) << 5); R = (st >> 1) * 16 + swz / 64; C = (st & 1) * 32 + (swz % 64) / 2; }
__host__ __device__ __forceinline__ int perm32(int rho) { const int n = rho >> 4, i = rho & 15; return 8 * (i >> 2) + 4 * n + (i & 3); }
struct Unit { int pm, pn, kh; };
struct Gemm { const bf16_t* A; const bf16_t* Bt; int K; int lda; size_t tstepB, hstepB; int ldb; size_t kofsA, kofsB; };
struct StaticOrder {
    int nM, nN, nwg, G, c, ksp;
    __host__ __device__ void init(int M_, int nN_, int G_, int c_, int ksp_ = 1) { nM = M_ / BM; nN = nN_; nwg = nM * nN; G = G_; c = c_; ksp = ksp_; }
    __host__ __device__ bool next(int i, Unit& u) const {
        const int ii = (ksp == 2) ? (i >> 1) : i; u.kh = (ksp == 2) ? (i & 1) : 0;
        const long L = (long)ii * G + c; if (L >= nwg) return false;
        int wgid = (int)L; { const int q = nwg / NXCD, r = nwg % NXCD, xcd = wgid % NXCD, off = wgid / NXCD; wgid = (xcd < r ? xcd * (q + 1) : r * (q + 1) + (xcd - r) * q) + off; }
        const int nig = WGM * nN, gid = wgid / nig, fm = gid * WGM, gsz = (nM - fm) < WGM ? (nM - fm) : WGM;
        u.pm = fm + ((wgid % nig) % gsz); u.pn = (wgid % nig) / gsz; return true;
    }
};
__device__ __forceinline__ unsigned cvt_pk_bf16(float lo, float hi) { unsigned r; asm volatile("v_cvt_pk_bf16_f32 %0, %1, %2" : "=v"(r) : "v"(lo), "v"(hi)); return r; }

struct EpiIn {
    static constexpr bool PERM = true, AFTER_DRAIN = false, HAS_MID = false;
    bf16_t* Z; float* stat;
    __device__ __forceinline__ void operator()(f32x4 (&acc)[2][2][4][2], const Unit& u, int wr, int wc, int fr, int fq, PG8_LAS unsigned char*) const {
        const int row0 = u.pm * BM + wr * 64 + fr, col0 = u.pn * BM + wc * 32 + 8 * fq, reg = u.pn >> 2;
#pragma unroll
        for (int ai = 0; ai < 2; ++ai)
#pragma unroll
            for (int m = 0; m < 4; ++m) { const int row = row0 + ai * HALF + m * 16; bf16_t* rowp = Z + (size_t)row * LDZ + col0; float s = 0.f, q = 0.f;
#pragma unroll
                for (int bj = 0; bj < 2; ++bj) { f32x4 v0 = acc[ai][bj][m][0], v1 = acc[ai][bj][m][1];
                    if (reg >= 1 && reg <= 3) {
#pragma unroll
                        for (int e = 0; e < 4; ++e) { v0[e] = gelu_f(v0[e]); v1[e] = gelu_f(v1[e]); } }
                    else if (reg >= 4) {
#pragma unroll
                        for (int e = 0; e < 4; ++e) { v0[e] = sigm_f(v0[e]); v1[e] = sigm_f(v1[e]); } }
                    if (reg == 3) {
#pragma unroll
                        for (int e = 0; e < 4; ++e) { s += v0[e] + v1[e]; q += v0[e] * v0[e] + v1[e] * v1[e]; } }
                    u32x4 w; w.x = cvt_pk_bf16(v0[0], v0[1]); w.y = cvt_pk_bf16(v0[2], v0[3]); w.z = cvt_pk_bf16(v1[0], v1[1]); w.w = cvt_pk_bf16(v1[2], v1[3]);
                    *(u32x4*)(rowp + bj * HALF) = w; }
                if (reg == 3) { s += __shfl_xor(s, 16); s += __shfl_xor(s, 32); q += __shfl_xor(q, 16); q += __shfl_xor(q, 32);
                    if (fq == 0) { atomicAdd(stat + 2 * row, s); atomicAdd(stat + 2 * row + 1, q); } } }
    }
};

template <int CTRL> __device__ __forceinline__ float dpp_f(float old, float src) { return __int_as_float(__builtin_amdgcn_update_dpp(__float_as_int(old), __float_as_int(src), CTRL, 0xf, 0xf, false)); }
typedef unsigned u32x2 __attribute__((ext_vector_type(2)));
struct EpiMerge {
    static constexpr bool PERM = true, AFTER_DRAIN = false, HAS_MID = true;
    bf16_t* Z;
    __device__ __forceinline__ void operator()(f32x4 (&acc)[2][2][4][2], const Unit& u, int wr, int wc, int fr, int fq, PG8_LAS unsigned char*) const {
        if (u.kh == 0) mid(acc, u, wr, wc, fr, fq); else fin(acc, u, wr, wc, fr, fq);
    }
    __device__ __forceinline__ void mid(f32x4 (&acc)[2][2][4][2], const Unit& u, int wr, int wc, int fr, int fq) const {
        const int row0 = u.pm * BM + wr * 64 + fr, col0 = u.pn * BM + wc * 32 + 8 * fq;
#pragma unroll
        for (int ai = 0; ai < 2; ++ai)
#pragma unroll
            for (int m = 0; m < 4; ++m) { const bf16_t* rowp = Z + (size_t)(row0 + ai * HALF + m * 16) * LDZ + col0;
#pragma unroll
                for (int bj = 0; bj < 2; ++bj) { const u32x4 a8 = *(const u32x4*)(rowp + ZC_GA + bj * HALF), b8 = *(const u32x4*)(rowp + ZC_GB + bj * HALF);
#pragma unroll
                    for (int e = 0; e < 8; ++e) { const unsigned aw = a8[e >> 1], bw = b8[e >> 1];
                        const float sa = (e & 1) ? __uint_as_float(aw & 0xffff0000u) : __uint_as_float(aw << 16), sb = (e & 1) ? __uint_as_float(bw & 0xffff0000u) : __uint_as_float(bw << 16);
                        acc[ai][bj][m][e >> 2][e & 3] *= sa * __builtin_amdgcn_rcpf(fmaxf(sb, 1e-20f)); } }
                asm volatile("" ::: "memory"); }
    }
    __device__ __forceinline__ void fin(f32x4 (&acc)[2][2][4][2], const Unit& u, int wr, int wc, int fr, int fq) const {
        const int row0 = u.pm * BM + wr * 64 + fr, col0 = u.pn * BM + wc * 32 + 8 * fq;
#pragma unroll
        for (int ai = 0; ai < 2; ++ai)
#pragma unroll
            for (int m = 0; m < 4; ++m) { bf16_t* rowp = Z + (size_t)(row0 + ai * HALF + m * 16) * LDZ + col0;
#pragma unroll
                for (int bj = 0; bj < 2; ++bj) { const u32x4 b8 = *(const u32x4*)(rowp + ZC_GB + bj * HALF); float o[8];
#pragma unroll
                    for (int e = 0; e < 8; ++e) { const unsigned bw = b8[e >> 1]; const float sb = (e & 1) ? __uint_as_float(bw & 0xffff0000u) : __uint_as_float(bw << 16);
                        o[e] = acc[ai][bj][m][e >> 2][e & 3] * fmaxf(sb, 1e-20f); }
                    u32x4 w; w.x = cvt_pk_bf16(o[0], o[1]); w.y = cvt_pk_bf16(o[2], o[3]); w.z = cvt_pk_bf16(o[4], o[5]); w.w = cvt_pk_bf16(o[6], o[7]);
                    *(u32x4*)(rowp + ZC_ZV + bj * HALF) = w; }
                asm volatile("" ::: "memory"); }
    }
};
struct EpiRes {
    static constexpr bool PERM = false, AFTER_DRAIN = false, HAS_MID = false;
    const float* base; const float* gate; float* out;
    __device__ __forceinline__ void operator()(f32x4 (&acc)[2][2][4][2], const Unit& u, int wr, int wc, int fr, int fq, PG8_LAS unsigned char*) const {
        const int row0 = u.pm * BM + wr * 64 + fr, col0 = u.pn * BM + wc * 32 + 4 * fq; const float* gp = gate + (u.pm >> 5) * 6144 + col0;
        f32x4 gv[2][2];
#pragma unroll
        for (int bj = 0; bj < 2; ++bj)
#pragma unroll
            for (int n = 0; n < 2; ++n) gv[bj][n] = *(const f32x4*)(gp + bj * HALF + 16 * n);
#pragma unroll
        for (int ai = 0; ai < 2; ++ai)
#pragma unroll
            for (int m = 0; m < 4; ++m) { const size_t off = (size_t)(row0 + ai * HALF + m * 16) * D + col0;
#pragma unroll
                for (int bj = 0; bj < 2; ++bj)
#pragma unroll
                    for (int n = 0; n < 2; ++n) { const f32x4 bs = *(const f32x4*)(base + off + bj * HALF + 16 * n); *(f32x4*)(out + off + bj * HALF + 16 * n) = bs + gv[bj][n] * acc[ai][bj][m][n]; }
                asm volatile("" ::: "memory"); }
    }
};
struct EpiUp {
    static constexpr bool PERM = true, AFTER_DRAIN = false, HAS_MID = false;
    bf16_t* Gd; const float* cw; const float* cb; float* head; float* tail;
    __device__ __forceinline__ void operator()(f32x4 (&acc)[2][2][4][2], const Unit& u, int wr, int wc, int fr, int fq, PG8_LAS unsigned char* xlds) const {
        const int colq = wc * 32 + 8 * fq;
        if (fr >= 14) {
#pragma unroll
            for (int ai = 0; ai < 2; ++ai)
#pragma unroll
                for (int bj = 0; bj < 2; ++bj)
#pragma unroll
                    for (int n = 0; n < 2; ++n) *(PG8_LAS f32x4*)(xlds + ((ai * 2 + wr) * 2 + (fr - 14)) * 1024 + (bj * HALF + colq + 4 * n) * 4) = acc[ai][bj][3][n];
            if (wr == 1) { float* tp = tail + ((size_t)(u.pm * 24 + u.pn) * 2 + (fr - 14)) * 256 + colq;
#pragma unroll
                for (int bj = 0; bj < 2; ++bj)
#pragma unroll
                    for (int n = 0; n < 2; ++n) *(f32x4*)(tp + bj * HALF + 4 * n) = acc[1][bj][3][n]; }
        }
        if (fr < 2 && wr == 0) { float* hp = head + ((size_t)(u.pm * 24 + u.pn) * 2 + fr) * 256 + colq;
#pragma unroll
            for (int bj = 0; bj < 2; ++bj)
#pragma unroll
                for (int n = 0; n < 2; ++n) *(f32x4*)(hp + bj * HALF + 4 * n) = acc[0][bj][0][n]; }
        asm volatile("s_waitcnt lgkmcnt(0)" ::: "memory"); __builtin_amdgcn_s_barrier(); asm volatile("" ::: "memory");
        const int row0 = u.pm * BM + wr * 64 + fr;
#pragma unroll
        for (int n = 0; n < 2; ++n) {
            const int j = u.pn * HALF + colq + 4 * n;
            const f32x4 w0a = *(const f32x4*)(cw + j), w1a = *(const f32x4*)(cw + NUP + j), w2a = *(const f32x4*)(cw + 2 * NUP + j), bba = *(const f32x4*)(cb + j);
            const f32x4 w0v = *(const f32x4*)(cw + DFF + j), w1v = *(const f32x4*)(cw + NUP + DFF + j), w2v = *(const f32x4*)(cw + 2 * NUP + DFF + j), bbv = *(const f32x4*)(cb + DFF + j);
#pragma unroll
            for (int ai = 0; ai < 2; ++ai) {
                const int gi = ai * 2 + wr - 1;
                f32x4 pa = {0.f, 0.f, 0.f, 0.f}, pv = {0.f, 0.f, 0.f, 0.f};
                if (gi >= 0 && fr >= 14) { pa = *(const PG8_LAS f32x4*)(xlds + (gi * 2 + (fr - 14)) * 1024 + (colq + 4 * n) * 4); pv = *(const PG8_LAS f32x4*)(xlds + (gi * 2 + (fr - 14)) * 1024 + (HALF + colq + 4 * n) * 4); }
#pragma unroll
                for (int m = 0; m < 4; ++m) { const f32x4 ca = acc[ai][0][m][n], cv = acc[ai][1][m][n]; float o[4];
#pragma unroll
                    for (int e = 0; e < 4; ++e) {
                        const float p1a = dpp_f<0x111>(dpp_f<0x121>(0.f, pa[e]), ca[e]), p2a = dpp_f<0x112>(dpp_f<0x122>(0.f, pa[e]), ca[e]);
                        const float p1v = dpp_f<0x111>(dpp_f<0x121>(0.f, pv[e]), cv[e]), p2v = dpp_f<0x112>(dpp_f<0x122>(0.f, pv[e]), cv[e]);
                        const float ua = bba[e] + w0a[e] * p2a + w1a[e] * p1a + w2a[e] * ca[e], uv = bbv[e] + w0v[e] * p2v + w1v[e] * p1v + w2v[e] * cv[e];
                        o[e] = gelu_f(ua) * uv; }
                    u32x2 w; w.x = cvt_pk_bf16(o[0], o[1]); w.y = cvt_pk_bf16(o[2], o[3]);
                    *(u32x2*)(Gd + (size_t)(row0 + ai * HALF + m * 16) * LDZ + j) = w;
                    pa = ca; pv = cv; }
            }
        }
    }
};

template <class Epi, bool ALIGN_EPI>
__device__ __forceinline__ void gemm_phase(PG8_LAS unsigned char* lds, PG8_LAS unsigned char* xlds, const Gemm g, const StaticOrder& S, const Epi& E) {
    const int tid = threadIdx.x, wid = __builtin_amdgcn_readfirstlane(tid >> 6), lane = tid & 63, wr = wid >> 2, wc = wid & 3, fr = lane & 15, fq = lane >> 4;
    const int K = g.K, nt = K / BK;
    unsigned voffA[2], voffB[2];
#pragma unroll
    for (int i = 0; i < 2; ++i) { int R, C; stage_rc(tid * 16 + i * 8192, R, C); const int Rb = Epi::PERM ? ((R & ~31) + perm32(R & 31)) : R;
        voffA[i] = (unsigned)(R * g.lda + C) * 2u; voffB[i] = (unsigned)(Rb * g.ldb + C) * 2u; }
    const size_t kstep = (size_t)(BK * 2);
    const size_t hstepA = (size_t)HALF * g.lda * 2, tstepA = 2 * hstepA, hstepB = g.hstepB, tstepB = g.tstepB;
    const unsigned ldsw = (unsigned)wid * 1024u;
    const int aoff = lds_byte(wr * 64 + fr, fq * 8), boff = lds_byte(wc * 32 + fr, fq * 8);
#define PG8_SA(b, h) (((b) * 2 + (h)) * HTB)
#define PG8_SB(b, h) ((4 + (b) * 2 + (h)) * HTB)
#define PG8_STAGE(bufoff, gbase, voff) do { _Pragma("unroll") for (int _i = 0; _i < 2; ++_i) \
        __builtin_amdgcn_global_load_lds((const unsigned*)((const char*)(gbase) + (voff)[_i]), (PG8_LAS unsigned*)(lds + (bufoff) + ldsw + _i * 8192), 16, 0, 0); } while (0)
#define PG8_LDA(dst, b, h) do { _Pragma("unroll") for (int m = 0; m < 4; ++m) _Pragma("unroll") for (int k = 0; k < 2; ++k) dst[m][k] = *(const PG8_LAS bf16x8*)(lds + PG8_SA(b, h) + aoff + m * 2048 + k * 1024); } while (0)
#define PG8_LDB(dst, b, h) do { _Pragma("unroll") for (int n = 0; n < 2; ++n) _Pragma("unroll") for (int k = 0; k < 2; ++k) dst[n][k] = *(const PG8_LAS bf16x8*)(lds + PG8_SB(b, h) + boff + n * 2048 + k * 1024); } while (0)
#define PG8_MMA(ai, bj, At, Bt) do { __builtin_amdgcn_s_setprio(1); _Pragma("unroll") for (int m = 0; m < 4; ++m) _Pragma("unroll") for (int n = 0; n < 2; ++n) _Pragma("unroll") for (int k = 0; k < 2; ++k) \
        acc[ai][bj][m][n] = __builtin_amdgcn_mfma_f32_16x16x32_bf16(Bt[n][k], At[m][k], acc[ai][bj][m][n], 0, 0, 0); __builtin_amdgcn_s_setprio(0); } while (0)
#define PG8_WAIT_V(n) asm volatile("s_waitcnt vmcnt(" #n ")" ::: "memory")
#define PG8_WAIT_L(n) asm volatile("s_waitcnt lgkmcnt(" #n ")" ::: "memory")
#define PG8_BAR __builtin_amdgcn_s_barrier()
#define PG8_SCHED __builtin_amdgcn_sched_barrier(0)
    Unit cur, nxt; int ui = 0;
    if (!S.next(0, cur)) return;
    f32x4 acc[2][2][4][2];
#pragma unroll
    for (int a = 0; a < 2; ++a)
#pragma unroll
        for (int b = 0; b < 2; ++b)
#pragma unroll
            for (int m = 0; m < 4; ++m)
#pragma unroll
                for (int n = 0; n < 2; ++n) acc[a][b][m][n] = (f32x4){0.f, 0.f, 0.f, 0.f};
    bf16x8 At[4][2], B0[2][2], B1[2][2];
    const char* cA = (const char*)g.A + (size_t)cur.pm * tstepA + cur.kh * g.kofsA; const char* cB = (const char*)g.Bt + (size_t)cur.pn * tstepB + cur.kh * g.kofsB;
    PG8_STAGE(PG8_SB(0, 0), cB, voffB); PG8_STAGE(PG8_SB(0, 1), cB + hstepB, voffB); PG8_STAGE(PG8_SA(0, 0), cA, voffA); PG8_STAGE(PG8_SA(0, 1), cA + hstepA, voffA);
    if (wr == 1) PG8_BAR;
    PG8_WAIT_V(2); PG8_BAR;
    PG8_STAGE(PG8_SB(1, 0), cB + kstep, voffB); PG8_STAGE(PG8_SA(1, 0), cA + kstep, voffA); PG8_STAGE(PG8_SB(1, 1), cB + hstepB + kstep, voffB);
    PG8_WAIT_V(6); PG8_BAR;
    for (;;) {
        const bool has_next = S.next(ui + 1, nxt);
        const char* nA = has_next ? (const char*)g.A + (size_t)nxt.pm * tstepA + nxt.kh * g.kofsA : cA; const char* nB = has_next ? (const char*)g.Bt + (size_t)nxt.pn * tstepB + nxt.kh * g.kofsB : cB;
        for (int t = 0; t < nt; t += 2) {
            const bool last = (t == nt - 2);
            const char* a1 = cA + (size_t)(t + 1) * kstep;
            const char* a2 = last ? nA : cA + (size_t)(t + 2) * kstep; const char* b2 = last ? nB : cB + (size_t)(t + 2) * kstep;
            const char* a3 = a2 + kstep; const char* b3 = b2 + kstep;
            PG8_LDB(B0, 0, 0); PG8_LDB(B1, 0, 1); PG8_SCHED; PG8_LDA(At, 0, 0); PG8_STAGE(PG8_SA(1, 1), a1 + hstepA, voffA);
            PG8_WAIT_V(8); PG8_WAIT_L(0); PG8_BAR; PG8_MMA(0, 0, At, B0); PG8_MMA(0, 1, At, B1); PG8_BAR; PG8_SCHED;
            PG8_LDA(At, 0, 1); PG8_STAGE(PG8_SB(0, 0), b2, voffB); PG8_STAGE(PG8_SB(0, 1), b2 + hstepB, voffB); PG8_STAGE(PG8_SA(0, 0), a2, voffA);
            PG8_WAIT_V(8); PG8_WAIT_L(0); PG8_BAR; PG8_MMA(1, 0, At, B0); PG8_MMA(1, 1, At, B1); PG8_BAR; PG8_SCHED;
            PG8_LDB(B0, 1, 0); PG8_LDB(B1, 1, 1); PG8_SCHED; PG8_LDA(At, 1, 0); PG8_STAGE(PG8_SA(0, 1), a2 + hstepA, voffA);
            PG8_WAIT_V(8); PG8_WAIT_L(0); PG8_BAR; PG8_MMA(0, 0, At, B0); PG8_MMA(0, 1, At, B1); PG8_BAR; PG8_SCHED;
            PG8_LDA(At, 1, 1); PG8_STAGE(PG8_SB(1, 0), b3, voffB); PG8_STAGE(PG8_SB(1, 1), b3 + hstepB, voffB); PG8_STAGE(PG8_SA(1, 0), a3, voffA);
            PG8_WAIT_V(8); PG8_WAIT_L(0); PG8_BAR; PG8_MMA(1, 0, At, B0); PG8_MMA(1, 1, At, B1); PG8_BAR; PG8_SCHED;
        }
        if constexpr (ALIGN_EPI) { if (wr == 0) PG8_BAR; }
        if constexpr (!Epi::AFTER_DRAIN) { E(acc, cur, wr, wc, fr, fq, xlds); }
        if (!has_next) break;
        if (!(Epi::HAS_MID && nxt.kh == 1))
#pragma unroll
        for (int a = 0; a < 2; ++a)
#pragma unroll
            for (int b = 0; b < 2; ++b)
#pragma unroll
                for (int m = 0; m < 4; ++m)
#pragma unroll
                    for (int n = 0; n < 2; ++n) acc[a][b][m][n] = (f32x4){0.f, 0.f, 0.f, 0.f};
        cur = nxt; cA = nA; cB = nB; ++ui;
        if constexpr (ALIGN_EPI) { if (wr == 1) PG8_BAR; }
    }
    PG8_WAIT_V(0);
    if constexpr (!ALIGN_EPI) { if (wr == 0) PG8_BAR; }
    PG8_BAR;
    if constexpr (Epi::AFTER_DRAIN) { E.fused(acc, cur, wr, wc, fr, fq, lds, wid, lane); }
#undef PG8_SA
#undef PG8_SB
#undef PG8_STAGE
#undef PG8_LDA
#undef PG8_LDB
#undef PG8_MMA
#undef PG8_WAIT_V
#undef PG8_WAIT_L
#undef PG8_BAR
#undef PG8_SCHED
}
}

constexpr int NWAVES = 8;
constexpr int RING_OFF = 0, RING_BYTES = 131072;
constexpr int XCH_OFF = RING_BYTES, XCH_BYTES = 12288;
constexpr int LDSCTL_OFF = XCH_OFF + XCH_BYTES, MISC_OFF = LDSCTL_OFF + 320;
constexpr int LDS_BYTES = 147456;
static_assert(MISC_OFF + 128 <= LDS_BYTES, "LDS map");

#define GAS __attribute__((address_space(1)))
#define LAS __attribute__((address_space(3)))
typedef unsigned v4u __attribute__((ext_vector_type(4)));
typedef float f32x4 __attribute__((ext_vector_type(4)));
typedef GAS unsigned gu32;
#define RLX_AGENT __ATOMIC_RELAXED, __HIP_MEMORY_SCOPE_AGENT
#define LDS_WAIT() asm volatile("s_waitcnt lgkmcnt(0)" ::: "memory")
#define VM_WAIT() asm volatile("s_waitcnt vmcnt(0)" ::: "memory")
__device__ __forceinline__ unsigned pk2(float lo, float hi) { return (unsigned)f2bf(lo) | ((unsigned)f2bf(hi) << 16); }

#define XB_TMO      128
#define XB_XCNT(j)  (256  + 64 * (j))
#define XB_XSUB(j)  (1280 + 64 * (j))
#define XB_XGEN(j)  (2304 + 64 * (j))
#define XB_TOP      3328
#define XB_TOPGEN   3392
#define XCD_BAR_WORDS 3456
#define XB_SPIN_CAP (1u << 18)
__device__ __forceinline__ unsigned xb_ld(unsigned* p)              { return __hip_atomic_load(p, __ATOMIC_RELAXED, __HIP_MEMORY_SCOPE_AGENT); }
__device__ __forceinline__ unsigned xb_add(unsigned* p, unsigned v) { return __hip_atomic_fetch_add(p, v, __ATOMIC_RELAXED, __HIP_MEMORY_SCOPE_AGENT); }
__device__ __forceinline__ unsigned xb_xcc_id() { return (unsigned)__builtin_amdgcn_s_getreg((3 << 11) | 20) & 0xFu; }
#define XB_SPIN(cond, bar) do { unsigned _sp = 0; while (cond) { __builtin_amdgcn_s_sleep(1); \
    if ((++_sp & 255u) == 0u) { if (xb_ld(&(bar)[XB_TMO])) break; if (_sp > XB_SPIN_CAP) { atomicAdd(&(bar)[XB_TMO], 1u); break; } } } } while (0)
struct XcdBarrier { unsigned* bar; unsigned x; volatile LAS unsigned* st; };
__device__ __forceinline__ XcdBarrier xcd_barrier_post(unsigned* bar, volatile LAS unsigned* st) {
    XcdBarrier b; b.bar = bar; b.x = xb_xcc_id(); b.st = st;
    if (threadIdx.x == 0) (void)xb_add(&bar[XB_XCNT(b.x)], 1u);
    return b;
}
__device__ __forceinline__ void xcd_barrier_complete(unsigned* bar, unsigned x, unsigned& nloc, unsigned& nx) {
    const unsigned G = gridDim.x * gridDim.y * gridDim.z;
    unsigned sum, cnt, mine, sp = 0u;
    for (;;) {
        sum = 0u; cnt = 0u; mine = 0u;
#pragma unroll
        for (unsigned j = 0; j < 16; ++j) { const unsigned c = xb_ld(&bar[XB_XCNT(j)]); sum += c; cnt += (c > 0u) ? 1u : 0u; mine = (j == x) ? c : mine; }
        if (sum == G) break;
        __builtin_amdgcn_s_sleep(1);
        if ((++sp & 255u) == 0u) { if (xb_ld(&bar[XB_TMO])) break; if (sp > XB_SPIN_CAP) { atomicAdd(&bar[XB_TMO], 1u); break; } }
    }
    nloc = mine > 0u ? mine : 1u; nx = cnt > 0u ? cnt : 1u;
}
__device__ __forceinline__ void xcd_barrier(const XcdBarrier& b) {
    asm volatile("s_waitcnt vmcnt(0)" ::: "memory");
    __syncthreads();
    if (threadIdx.x == 0) {
        unsigned* bar = b.bar;
        __builtin_amdgcn_s_waitcnt(0);
        unsigned nloc = b.st[0], nx = b.st[1];
        if (nloc == 0u) { xcd_barrier_complete(bar, b.x, nloc, nx); b.st[0] = nloc; b.st[1] = nx; }
        const unsigned old = xb_add(&bar[XB_XSUB(b.x)], 1u);
        const unsigned gen = old / nloc;
        if (old + 1u == (gen + 1u) * nloc) {
            __builtin_amdgcn_fence(__ATOMIC_RELEASE, "agent");
            asm volatile("s_waitcnt vmcnt(0)" ::: "memory");
            const unsigned og = xb_add(&bar[XB_TOP], 1u);
            const unsigned tg = og / nx;
            if (og + 1u == (tg + 1u) * nx) xb_add(&bar[XB_TOPGEN], 1u);
            else XB_SPIN(xb_ld(&bar[XB_TOPGEN]) == tg, bar);
            __builtin_amdgcn_fence(__ATOMIC_ACQUIRE, "agent");
            xb_add(&bar[XB_XGEN(b.x)], 1u);
            asm volatile("s_waitcnt vmcnt(0)" ::: "memory");
        } else {
            XB_SPIN(xb_ld(&bar[XB_XGEN(b.x)]) == gen, bar);
            __builtin_amdgcn_fence(__ATOMIC_ACQUIRE, "agent");
            asm volatile("s_waitcnt vmcnt(0)" ::: "memory");
        }
    }
    __syncthreads();
}

struct Args { const float* in[26]; float* out; unsigned char* ws; int ph_lo, ph_hi, li, pad; };
enum { PH_PRO = 0, PH_H1 = 1, PH_GIN = 2, PH_MIX = 3, PH_FIX = 4, PH_MRG = 5, PH_OUT = 6, PH_H2 = 7, PH_UP = 8, PH_UPFIX = 9, PH_DOWN = 10, PH_FIN = 11, PH_END = 12 };

__device__ __forceinline__ float wave_sum(float v) {
#pragma unroll
    for (int o = 1; o < 64; o <<= 1) v += __shfl_xor(v, o);
    return v;
}
__device__ __forceinline__ void p0_transpose_item(const float* W, int N, bf16_t* WT, int ldk, int row_off, int k_off, LAS float* scr, int item, int lane) {
    const int nblk = N / 32, kb = item / nblk, nb = item % nblk, k0 = 64 * kb, n0 = 32 * nb;
#pragma unroll 8
    for (int i = 0; i < 32; ++i) { const int kk = 2 * i + (lane >> 5); scr[kk * 33 + (lane & 31)] = W[(size_t)(k0 + kk) * N + n0 + (lane & 31)]; }
    LDS_WAIT(); asm volatile("" ::: "memory");
    const int c = lane & 7;
#pragma unroll
    for (int j = 0; j < 4; ++j) { const int n = (lane >> 3) + 8 * j; const LAS float* s = scr + (8 * c) * 33 + n;
        v4u o; o.x = pk2(s[0 * 33], s[1 * 33]); o.y = pk2(s[2 * 33], s[3 * 33]); o.z = pk2(s[4 * 33], s[5 * 33]); o.w = pk2(s[6 * 33], s[7 * 33]);
        *(GAS v4u*)(WT + (size_t)(row_off + n0 + n) * ldk + k_off + k0 + 8 * c) = o; }
    LDS_WAIT(); asm volatile("" ::: "memory");
}


typedef float f32x16 __attribute__((ext_vector_type(16)));
typedef short bf16x8 __attribute__((ext_vector_type(8)));
typedef float f32x2v __attribute__((ext_vector_type(2)));
constexpr int XS = 272;
__device__ __forceinline__ void rnn_unit(LAS unsigned char* lds, int pm, int hd, const bf16_t* Z, const bf16_t* Lru, const float* cw, const float* cb, const float* ba, const float* bx,
                                         const float* lam, unsigned* HP, f32x2v* SUMM, int tid, int lane, int wave) {
    const int m0 = pm * 256;
    {
        const int cp = tid & 63, rg = wave, ch = hd * 128 + 2 * cp;
        const unsigned* src = (const unsigned*)(Z + ZC_XR + ch) + (size_t)(m0 + rg * 32 - 3) * (LDZ / 2);
        const bool has_halo = (rg > 0) || ((pm & 31) != 0);
        unsigned raw[35];
#pragma unroll
        for (int i = 0; i < 35; ++i) raw[i] = (i >= 3 || has_halo) ? src[(size_t)i * (LDZ / 2)] : 0u;
        const f32x2v w0 = *(const f32x2v*)(cw + 0 * D + ch), w1 = *(const f32x2v*)(cw + 1 * D + ch), w2 = *(const f32x2v*)(cw + 2 * D + ch), w3 = *(const f32x2v*)(cw + 3 * D + ch), bb = *(const f32x2v*)(cb + ch);
        f32x2v x3 = {__uint_as_float(raw[0] << 16), __uint_as_float(raw[0] & 0xffff0000u)}, x2 = {__uint_as_float(raw[1] << 16), __uint_as_float(raw[1] & 0xffff0000u)}, x1 = {__uint_as_float(raw[2] << 16), __uint_as_float(raw[2] & 0xffff0000u)};
        LAS unsigned* dst = (LAS unsigned*)(lds + (rg * 32) * XS + cp * 4);
#pragma unroll
        for (int i = 0; i < 32; ++i) { const f32x2v x0 = {__uint_as_float(raw[i + 3] << 16), __uint_as_float(raw[i + 3] & 0xffff0000u)};
            const f32x2v y = bb + w0 * x3 + w1 * x2 + w2 * x1 + w3 * x0; x3 = x2; x2 = x1; x1 = x0;
            dst[i * (XS / 4)] = pk2(y.x, y.y); }
    }
    LDS_WAIT(); __syncthreads();
    const int cg = wave & 3, th = wave >> 2, r = lane & 31, h = lane >> 5, ch = hd * 128 + cg * 32 + r;
    f32x16 aa[4], ax[4];
    {
        const bf16_t* lbp = Lru + (size_t)hd * 256 * 128 + (size_t)(cg * 32 + r) * 128 + 8 * h;
        bf16x8 Ba[8], Bx[8];
#pragma unroll
        for (int ks = 0; ks < 8; ++ks) { Ba[ks] = *(const bf16x8*)(lbp + 16 * ks); Bx[ks] = *(const bf16x8*)(lbp + 128 * 128 + 16 * ks); }
        const LAS unsigned char* abase = lds + (th * 128 + r) * XS + h * 16;
#pragma unroll
        for (int tt = 0; tt < 4; ++tt) {
#pragma unroll
            for (int e = 0; e < 16; ++e) { aa[tt][e] = 0.f; ax[tt][e] = 0.f; }
#pragma unroll
            for (int ks = 0; ks < 8; ++ks) { const bf16x8 A = *(const LAS bf16x8*)(abase + tt * 32 * XS + ks * 32);
                aa[tt] = __builtin_amdgcn_mfma_f32_32x32x16_bf16(A, Ba[ks], aa[tt], 0, 0, 0); ax[tt] = __builtin_amdgcn_mfma_f32_32x32x16_bf16(A, Bx[ks], ax[tt], 0, 0, 0); } }
    }
    const float bav = ba[ch], bxv = bx[ch], lsl2 = -8.f * 1.4426950408889634f * log1pf(expf(-lam[ch]));
    const LAS unsigned short* xcol = (const LAS unsigned short*)(lds + (th * 128) * XS + (cg * 32 + r) * 2);
    float cP = 1.f, cH = 0.f;
    unsigned* hp = HP + (size_t)(m0 + th * 128) * D + ch;
#pragma unroll
    for (int tt = 0; tt < 4; ++tt) {
#pragma unroll
        for (int e = 0; e < 16; ++e) { const int trow = (e & 3) + 8 * (e >> 2) + 4 * h; const float xcv = bf2f(xcol[(tt * 32 + trow) * (XS / 2)]);
            const float rg_ = sigm_f(aa[tt][e] + bav), ig = sigm_f(ax[tt][e] + bxv); const float a = __builtin_amdgcn_exp2f(rg_ * lsl2);
            const float mult = __builtin_amdgcn_sqrtf(fmaxf(0.f, 1.f - a * a)); aa[tt][e] = a; ax[tt][e] = mult * (ig * xcv); }
#pragma unroll
        for (int q = 0; q < 4; ++q) {
            float p = aa[tt][4 * q], hl = ax[tt][4 * q];
#pragma unroll
            for (int j = 1; j < 4; ++j) { const float a = aa[tt][4 * q + j]; hl = a * hl + ax[tt][4 * q + j]; p *= a; aa[tt][4 * q + j] = p; ax[tt][4 * q + j] = hl; }
            const float Ame = p, Hme = hl, Ao = __shfl_xor(Ame, 32), Ho = __shfl_xor(Hme, 32);
            const float A1 = h ? Ao : Ame, H1 = h ? Ho : Hme, A2 = h ? Ame : Ao, H2 = h ? Hme : Ho;
            const float midP = A1 * cP, midH = A1 * cH + H1;
            const float inP = h ? midP : cP, inH = h ? midH : cH;
#pragma unroll
            for (int j = 0; j < 4; ++j) { const int e = 4 * q + j, trow = j + 8 * q + 4 * h;
                hp[(size_t)(tt * 32 + trow) * D] = pk2(ax[tt][e] + aa[tt][e] * inH, aa[tt][e] * inP); }
            cP = A2 * midP; cH = A2 * midH + H2;
        }
    }
    if (h == 0) SUMM[(size_t)(pm * 2 + th) * D + ch] = (f32x2v){cP, cH};
    __syncthreads();
}
__device__ __forceinline__ void sgu_unit(LAS unsigned char* lds, int nb, int g, bf16_t* Z, const float* stat, const float* lg, const float* lbb, const bf16_t* Wm, const float* bs, int tid, int lane, int wave) {
    {
        const int dc = tid & 15, ch0 = g * 128 + 8 * dc;
        const f32x4 g0 = *(const f32x4*)(lg + ch0), g1 = *(const f32x4*)(lg + ch0 + 4), b0 = *(const f32x4*)(lbb + ch0), b1 = *(const f32x4*)(lbb + ch0 + 4);
#pragma unroll
        for (int i = 0; i < 2; ++i) { const int s0 = 2 * ((tid >> 4) + 32 * i); const size_t m = (size_t)nb * 128 + s0;
            const v4u v0 = *(const v4u*)(Z + m * LDZ + ZC_ZV + ch0), v1 = *(const v4u*)(Z + (m + 1) * LDZ + ZC_ZV + ch0);
            const f32x2v st0 = *(const f32x2v*)(stat + 2 * m), st1 = *(const f32x2v*)(stat + 2 * (m + 1));
            const float mean0 = st0.x * (1.f / D), mean1 = st1.x * (1.f / D);
            const float rs0 = rsqrtf(fmaxf(st0.y * (1.f / D) - mean0 * mean0, 0.f) + 1e-6f), rs1 = rsqrtf(fmaxf(st1.y * (1.f / D) - mean1 * mean1, 0.f) + 1e-6f);
#pragma unroll
            for (int e = 0; e < 8; ++e) { const unsigned w0 = v0[e >> 1], w1 = v1[e >> 1];
                const float x0 = (e & 1) ? __uint_as_float(w0 & 0xffff0000u) : __uint_as_float(w0 << 16), x1 = (e & 1) ? __uint_as_float(w1 & 0xffff0000u) : __uint_as_float(w1 << 16);
                const float gg = (e < 4) ? g0[e & 3] : g1[e & 3], bb = (e < 4) ? b0[e & 3] : b1[e & 3];
                const int d = 8 * dc + e;
                *(LAS unsigned*)(lds + d * XS + (((s0 >> 3) ^ ((d >> 3) & 15)) * 16) + (s0 & 7) * 2) = pk2((x0 - mean0) * rs0 * gg + bb, (x1 - mean1) * rs1 * gg + bb); }
        }
    }
    LDS_WAIT(); __syncthreads();
    const int tt = wave >> 1, dd0 = 2 * (wave & 1), r = lane & 31, h = lane >> 5;
    f32x16 c0, c1;
#pragma unroll
    for (int e = 0; e < 16; ++e) { c0[e] = 0.f; c1[e] = 0.f; }
    {
        const bf16_t* wa = Wm + ((size_t)g * 128 + tt * 32 + r) * 128 + 8 * h;
        const int d0 = dd0 * 32 + r, d1 = d0 + 32;
#pragma unroll
        for (int ks = 0; ks < 8; ++ks) if (ks <= 2 * tt + 1) {
            const bf16x8 A = *(const bf16x8*)(wa + 16 * ks);
            const bf16x8 B0 = *(const LAS bf16x8*)(lds + d0 * XS + (((2 * ks + h) ^ ((d0 >> 3) & 15)) * 16));
            const bf16x8 B1 = *(const LAS bf16x8*)(lds + d1 * XS + (((2 * ks + h) ^ ((d1 >> 3) & 15)) * 16));
            c0 = __builtin_amdgcn_mfma_f32_32x32x16_bf16(A, B0, c0, 0, 0, 0); c1 = __builtin_amdgcn_mfma_f32_32x32x16_bf16(A, B1, c1, 0, 0, 0); }
    }
#pragma unroll
    for (int e = 0; e < 16; ++e) { const int t = tt * 32 + (e & 3) + 8 * (e >> 2) + 4 * h; const float bsv = bs[g * 128 + t];
        bf16_t* p = Z + ((size_t)nb * 128 + t) * LDZ + ZC_ZU + g * 128 + dd0 * 32 + r;
        p[0] = f2bf(bf2f(p[0]) * (c0[e] + bsv)); p[32] = f2bf(bf2f(p[32]) * (c1[e] + bsv)); }
    __syncthreads();
}

__global__ void __launch_bounds__(NWAVES * 64, 2) mega(Args args) {
    extern __shared__ __attribute__((aligned(16))) unsigned char lds_raw[];
    LAS unsigned char* lds = (LAS unsigned char*)lds_raw;
    volatile LAS unsigned* MISC = (volatile LAS unsigned*)(lds + MISC_OFF);
    const int tid = threadIdx.x, lane = tid & 63, wave = __builtin_amdgcn_readfirstlane(tid >> 6);
    const int G = gridDim.x; const int bx = blockIdx.x; const int vcu = (G % 8 == 0) ? (bx % 8) * (G / 8) + bx / 8 : bx;
    unsigned char* ws = args.ws;
    gu32* ctl = (gu32*)(ws + WS_CTL);
    const float* x = args.in[0]; float* out = args.out;
    float* mod = (float*)(ws + WS_MOD); float* stat = (float*)(ws + WS_STAT);
    bf16_t* Win = (bf16_t*)(ws + WS_WIN); bf16_t* Wup = (bf16_t*)(ws + WS_WUP); bf16_t* Wdn = (bf16_t*)(ws + WS_WDN); bf16_t* Wab = (bf16_t*)(ws + WS_WAB);
    bf16_t* Wo = (bf16_t*)(ws + WS_WO); bf16_t* Lru = (bf16_t*)(ws + WS_LRU); bf16_t* Wm = (bf16_t*)(ws + WS_WM); bf16_t* Z = (bf16_t*)(ws + WS_Z);
    bf16_t* H1 = (bf16_t*)out;
    for (int u = tid; u < (LDS_BYTES - LDSCTL_OFF) / 4; u += NWAVES * 64) ((LAS unsigned*)(lds + LDSCTL_OFF))[u] = 0u;
    __syncthreads();
    XcdBarrier bar = xcd_barrier_post((unsigned*)(ctl + CW_BAR) + args.li * XCD_BAR_WORDS, MISC + 8);
    const int lo = args.ph_lo, hi = args.ph_hi;
#define IN(k) (lo <= (k) && (k) < hi)
#define SEAM(k) do { if (IN(k) && IN((k) + 1)) xcd_barrier(bar); } while (0)
    const int gw = vcu * NWAVES + wave, NGW = G * NWAVES;

    if (IN(PH_PRO)) {
        for (int it = bx; it < 256; it += G) {
            const int kc = it >> 2, nc = it & 3; const float* wa = args.in[2]; const float* cc = args.in[1];
            float a0[3] = {0.f, 0.f, 0.f}, a1[3] = {0.f, 0.f, 0.f};
            for (int kk = 0; kk < 16; ++kk) { const int k = kc * 16 + kk; const float c0 = cc[k], c1 = cc[D + k]; const float s0 = c0 * sigm(c0), s1 = c1 * sigm(c1);
#pragma unroll
                for (int j = 0; j < 3; ++j) { const float w = wa[(size_t)k * 6144 + nc * 1536 + tid + 512 * j]; a0[j] += s0 * w; a1[j] += s1 * w; } }
#pragma unroll
            for (int j = 0; j < 3; ++j) { const int n = nc * 1536 + tid + 512 * j; const float bb = (kc == 0) ? args.in[3][n] : 0.f;
                atomicAdd(mod + n, a0[j] + bb); atomicAdd(mod + 6144 + n, a1[j] + bb); }
        }
        LAS float* scr = (LAS float*)(lds + RING_OFF + wave * 16384);
        constexpr int I_IN = 16 * 192, I_UP = 16 * 192, I_DN = 48 * 32, I_SQ = 16 * 32, I_LRU = 16 * 8;
        constexpr int NITEMS = I_IN + I_UP + I_DN + 3 * I_SQ + I_LRU;
        for (int it = gw; it < NITEMS; it += NGW) {
            int r = it;
            if (r < I_IN) { p0_transpose_item(args.in[5], NIN, Win, D, 0, 0, scr, r, lane); continue; } r -= I_IN;
            if (r < I_UP) { p0_transpose_item(args.in[21], NUP, Wup, D, 0, 0, scr, r, lane); continue; } r -= I_UP;
            if (r < I_DN) { p0_transpose_item(args.in[24], D, Wdn, DFF, 0, 0, scr, r, lane); continue; } r -= I_DN;
            if (r < I_SQ) { p0_transpose_item(args.in[17], D, Wab, 2048, 0, 0, scr, r, lane); continue; } r -= I_SQ;
            if (r < I_SQ) { p0_transpose_item(args.in[18], D, Wab, 2048, 0, 1024, scr, r, lane); continue; } r -= I_SQ;
            if (r < I_SQ) { p0_transpose_item(args.in[19], D, Wo, D, 0, 0, scr, r, lane); continue; } r -= I_SQ;
            { const int mat = r >> 3, hd = mat >> 1, isx = mat & 1; p0_transpose_item((isx ? args.in[10] : args.in[8]) + (size_t)hd * 16384, 128, Lru + (size_t)hd * 256 * 128, 128, isx * 128, 0, scr, r & 7, lane); }
        }
        for (int e = bx * 512 + tid; e < 8 * 128 * 128; e += G * 512) { const int s = e & 127, t = (e >> 7) & 127; Wm[e] = (s <= t) ? f2bf(args.in[15][e]) : (bf16_t)0; }
    }
    SEAM(PH_PRO);
    if (IN(PH_H1)) {
        const float* gm = args.in[4];
        for (int bb = 0; bb < BATCH; ++bb) {
            f32x4 gs[4], sh[4];
#pragma unroll
            for (int j = 0; j < 4; ++j) { const int c = 4 * lane + 256 * j; const f32x4 g4 = *(const f32x4*)(gm + c), sc = *(const f32x4*)(mod + bb * 6144 + 1024 + c); sh[j] = *(const f32x4*)(mod + bb * 6144 + c); gs[j] = g4 * (sc + 1.0f); }
            for (int m = bb * SEQ + gw; m < (bb + 1) * SEQ; m += NGW) {
                const GAS f32x4* xr = (const GAS f32x4*)(x + (size_t)m * D) + lane; f32x4 v[4]; float s = 0.f;
#pragma unroll
                for (int j = 0; j < 4; ++j) { v[j] = xr[64 * j]; s += (v[j].x * v[j].x + v[j].y * v[j].y) + (v[j].z * v[j].z + v[j].w * v[j].w); }
                const float rstd = 1.f / sqrtf(wave_sum(s) * (1.f / D) + 1e-6f);
                GAS unsigned long long* o8 = (GAS unsigned long long*)(H1 + (size_t)m * D) + lane;
#pragma unroll
                for (int j = 0; j < 4; ++j) { const f32x4 y = v[j] * rstd * gs[j] + sh[j]; o8[64 * j] = (unsigned long long)pk2(y.x, y.y) | ((unsigned long long)pk2(y.z, y.w) << 32); }
            }
        }
    }
    SEAM(PH_H1);
    if (IN(PH_GIN)) {
        pg8::Gemm g{H1, Win, D, D, (size_t)256 * D * 2, (size_t)128 * D * 2, D, 0, 0}; pg8::StaticOrder S; S.init(M, NIN / 256, G, bx);
        pg8::EpiIn E{Z, stat};
        pg8::gemm_phase<pg8::EpiIn, true>(lds + RING_OFF, lds + XCH_OFF, g, S, E);
    }
    SEAM(PH_GIN);
    if (IN(PH_MIX)) {
        unsigned* HP = (unsigned*)out; f32x2v* SUMM = (f32x2v*)(ws + WS_SUMM);
        for (int u = bx; u < 512; u += G) rnn_unit(lds + RING_OFF, u >> 3, u & 7, Z, Lru, args.in[6], args.in[7], args.in[9], args.in[11], args.in[12], HP, SUMM, tid, lane, wave);
        for (int u = bx; u < 1024; u += G) sgu_unit(lds + RING_OFF, u >> 3, u & 7, Z, stat, args.in[13], args.in[14], Wm, args.in[16], tid, lane, wave);
    }
    SEAM(PH_MIX);
    if (IN(PH_FIX)) {
        const unsigned* HP = (const unsigned*)out; const f32x4* SUMM4 = (const f32x4*)(ws + WS_SUMM);
        for (int it = gw; it < 4096; it += NGW) {
            const int qr = it & 3, hd = (it >> 2) & 7, w = it >> 5; const int chp = hd * 64 + lane;
            float c0 = 0.f, c1 = 0.f;
            for (int wp = (w & ~63); wp < w; ++wp) { const f32x4 sm = SUMM4[(size_t)wp * 512 + chp]; c0 = sm.x * c0 + sm.y; c1 = sm.z * c1 + sm.w; }
            const size_t mrow = (size_t)w * 128 + qr * 32;
#pragma unroll 8
            for (int rr = 0; rr < 32; ++rr) { const size_t m = mrow + rr;
                const unsigned long long hp2 = *(const unsigned long long*)(HP + m * D + 2 * chp); unsigned* gp = (unsigned*)(Z + m * LDZ + ZC_GR) + chp; const unsigned gr2 = *gp;
                const unsigned a = (unsigned)hp2, b = (unsigned)(hp2 >> 32);
                const float y0 = (__uint_as_float(a << 16) + __uint_as_float(a & 0xffff0000u) * c0) * __uint_as_float(gr2 << 16);
                const float y1 = (__uint_as_float(b << 16) + __uint_as_float(b & 0xffff0000u) * c1) * __uint_as_float(gr2 & 0xffff0000u);
                *gp = pk2(y0, y1); }
        }
    }
    SEAM(PH_FIX);
    if (IN(PH_MRG)) {
        pg8::Gemm g{Z + ZC_GR, Wab, D, LDZ, (size_t)256 * 2048 * 2, (size_t)128 * 2048 * 2, 2048, (size_t)D * 2, (size_t)D * 2}; pg8::StaticOrder S; S.init(M, 4, G, bx, 2);
        pg8::EpiMerge E{Z};
        pg8::gemm_phase<pg8::EpiMerge, true>(lds + RING_OFF, lds + XCH_OFF, g, S, E);
    }
    SEAM(PH_MRG);
    if (IN(PH_OUT)) {
        pg8::Gemm g{Z + ZC_ZV, Wo, D, LDZ, (size_t)256 * D * 2, (size_t)128 * D * 2, D, 0, 0}; pg8::StaticOrder S; S.init(M, 4, G, bx);
        pg8::EpiRes E{x, mod + 2048, out};
        pg8::gemm_phase<pg8::EpiRes, true>(lds + RING_OFF, lds + XCH_OFF, g, S, E);
    }
    SEAM(PH_OUT);
    if (IN(PH_H2)) {
        const float* gm = args.in[20];
        for (int bb = 0; bb < BATCH; ++bb) {
            f32x4 gs[4], sh[4];
#pragma unroll
            for (int j = 0; j < 4; ++j) { const int c = 4 * lane + 256 * j; const f32x4 g4 = *(const f32x4*)(gm + c), sc = *(const f32x4*)(mod + bb * 6144 + 4096 + c); sh[j] = *(const f32x4*)(mod + bb * 6144 + 3072 + c); gs[j] = g4 * (sc + 1.0f); }
            for (int m = bb * SEQ + gw; m < (bb + 1) * SEQ; m += NGW) {
                const GAS f32x4* xr = (const GAS f32x4*)(out + (size_t)m * D) + lane; f32x4 v[4]; float s = 0.f;
#pragma unroll
                for (int j = 0; j < 4; ++j) { v[j] = xr[64 * j]; s += (v[j].x * v[j].x + v[j].y * v[j].y) + (v[j].z * v[j].z + v[j].w * v[j].w); }
                const float rstd = 1.f / sqrtf(wave_sum(s) * (1.f / D) + 1e-6f);
                GAS unsigned long long* o8 = (GAS unsigned long long*)(Z + (size_t)m * LDZ + ZC_XR) + lane;
#pragma unroll
                for (int j = 0; j < 4; ++j) { const f32x4 y = v[j] * rstd * gs[j] + sh[j]; o8[64 * j] = (unsigned long long)pk2(y.x, y.y) | ((unsigned long long)pk2(y.z, y.w) << 32); }
            }
        }
    }
    SEAM(PH_H2);
    if (IN(PH_UP)) {
        pg8::Gemm g{Z + ZC_XR, Wup, D, LDZ, (size_t)128 * D * 2, (size_t)DFF * D * 2, D, 0, 0}; pg8::StaticOrder S; S.init(M, 24, G, bx);
        pg8::EpiUp E{Z + 3072, args.in[22], args.in[23], (float*)(ws + WS_HEAD), (float*)(ws + WS_TAIL)};
        pg8::gemm_phase<pg8::EpiUp, true>(lds + RING_OFF, lds + XCH_OFF, g, S, E);
    }
    SEAM(PH_UP);
    if (IN(PH_UPFIX)) {
        const float* head = (const float*)(ws + WS_HEAD); const float* tail = (const float*)(ws + WS_TAIL); const float* cw = args.in[22]; const float* cb = args.in[23];
        for (int it = bx * 512 + tid; it < 64 * 24 * 128; it += G * 512) {
            const int c = it & 127, tl = it >> 7, pn = tl % 24, pm = tl / 24, j = pn * 128 + c; const bool hh = (pm & 31) != 0;
            const float* hp = head + (size_t)tl * 512; const float* tp = tail + (size_t)(tl - 24) * 512;
            float o[2][2];
#pragma unroll
            for (int v = 0; v < 2; ++v) { const int cc = c + 128 * v, jj = j + DFF * v;
                const float t0 = hh ? tp[cc] : 0.f, t1 = hh ? tp[256 + cc] : 0.f, h0 = hp[cc], h1 = hp[256 + cc];
                const float w0 = cw[jj], w1 = cw[NUP + jj], w2 = cw[2 * NUP + jj], b = cb[jj];
                o[v][0] = b + w0 * t0 + w1 * t1 + w2 * h0; o[v][1] = b + w0 * t1 + w1 * h0 + w2 * h1; }
            bf16_t* gp = Z + (size_t)(pm * 256) * LDZ + 3072 + j;
            gp[0] = f2bf(gelu_f(o[0][0]) * o[1][0]); gp[LDZ] = f2bf(gelu_f(o[0][1]) * o[1][1]);
        }
    }
    SEAM(PH_UPFIX);
    if (IN(PH_DOWN)) {
        pg8::Gemm g{Z + 3072, Wdn, DFF, LDZ, (size_t)256 * DFF * 2, (size_t)128 * DFF * 2, DFF, 0, 0}; pg8::StaticOrder S; S.init(M, 4, G, bx);
        pg8::EpiRes E{out, mod + 5120, out};
        pg8::gemm_phase<pg8::EpiRes, true>(lds + RING_OFF, lds + XCH_OFF, g, S, E);
    }
    SEAM(PH_DOWN);
    if (IN(PH_FIN)) {
        const float* gm = args.in[25]; f32x4 gs[4];
#pragma unroll
        for (int j = 0; j < 4; ++j) gs[j] = *(const f32x4*)(gm + 4 * lane + 256 * j);
        for (int m = gw; m < M; m += NGW) {
            GAS f32x4* xr = (GAS f32x4*)(out + (size_t)m * D) + lane; f32x4 v[4]; float s = 0.f;
#pragma unroll
            for (int j = 0; j < 4; ++j) { v[j] = xr[64 * j]; s += (v[j].x * v[j].x + v[j].y * v[j].y) + (v[j].z * v[j].z + v[j].w * v[j].w); }
            const float rstd = 1.f / sqrtf(wave_sum(s) * (1.f / D) + 1e-6f);
#pragma unroll
            for (int j = 0; j < 4; ++j) xr[64 * j] = v[j] * rstd * gs[j];
        }
    }
#undef IN
#undef SEAM
}

__global__ void k_modnorm(const float* __restrict__ x, const float* __restrict__ g, const float* __restrict__ mod, int shift_off, int scale_off, bf16_t* __restrict__ out, int ldo) {
    __shared__ float red[256];
    const int m = blockIdx.x, bb = m / SEQ, tid = threadIdx.x;
    float v[4], s = 0.f;
    for (int i = 0; i < 4; ++i) { v[i] = x[(size_t)m * D + tid + 256 * i]; s += v[i] * v[i]; }
    red[tid] = s; __syncthreads();
    for (int o = 128; o > 0; o >>= 1) { if (tid < o) red[tid] += red[tid + o]; __syncthreads(); }
    const float rstd = rsqrtf(red[0] * (1.f / D) + 1e-6f);
    for (int i = 0; i < 4; ++i) { const int cidx = tid + 256 * i; const float y = v[i] * rstd * g[cidx];
        out[(size_t)m * ldo + cidx] = f2bf(y * (1.f + mod[bb * 6144 + scale_off + cidx]) + mod[bb * 6144 + shift_off + cidx]); }
}
__global__ void k_final(float* __restrict__ x, const float* __restrict__ g) {
    __shared__ float red[256];
    const int m = blockIdx.x, tid = threadIdx.x;
    float v[4], s = 0.f;
    for (int i = 0; i < 4; ++i) { v[i] = x[(size_t)m * D + tid + 256 * i]; s += v[i] * v[i]; }
    red[tid] = s; __syncthreads();
    for (int o = 128; o > 0; o >>= 1) { if (tid < o) red[tid] += red[tid + o]; __syncthreads(); }
    const float rstd = rsqrtf(red[0] * (1.f / D) + 1e-6f);
    for (int i = 0; i < 4; ++i) { const int cidx = tid + 256 * i; x[(size_t)m * D + cidx] = v[i] * rstd * g[cidx]; }
}
struct GP { const bf16_t* A; int lda; const bf16_t* Bt; int ldb; int K; int mode; bf16_t* Z; const float* x; float* out; const float* mod; float* tmp; };
enum { MODE_IN = 0, MODE_BRA = 1, MODE_BRB = 2, MODE_OUT = 3, MODE_DOWN = 4 };
__global__ void __launch_bounds__(256) k_gemm(GP p) {
    __shared__ float As[64][33], Bs[64][33];
    const int tid = threadIdx.x, tx = tid & 15, ty = tid >> 4, m0 = blockIdx.y * 64, n0 = blockIdx.x * 64;
    float acc[4][4] = {};
    const int lr = tid >> 2, lk = (tid & 3) * 8;
    for (int k0 = 0; k0 < p.K; k0 += 32) {
        const bf16_t* ap = p.A + (size_t)(m0 + lr) * p.lda + k0 + lk; const bf16_t* bp = p.Bt + (size_t)(n0 + lr) * p.ldb + k0 + lk;
        for (int i = 0; i < 8; ++i) { As[lr][lk + i] = bf2f(ap[i]); Bs[lr][lk + i] = bf2f(bp[i]); }
        __syncthreads();
        for (int k = 0; k < 32; ++k) { float a[4], b[4];
            for (int i = 0; i < 4; ++i) { a[i] = As[ty * 4 + i][k]; b[i] = Bs[tx * 4 + i][k]; }
            for (int i = 0; i < 4; ++i) for (int j = 0; j < 4; ++j) acc[i][j] += a[i] * b[j]; }
        __syncthreads();
    }
    for (int i = 0; i < 4; ++i) for (int j = 0; j < 4; ++j) {
        const int m = m0 + ty * 4 + i, n = n0 + tx * 4 + j, bb = m / SEQ; const float v = acc[i][j];
        if (p.mode == MODE_IN) { const int reg = n >> 10; float o = v; if (reg >= 1 && reg <= 3) o = gelu_t(v); else if (reg >= 4) o = sigm(v); p.Z[(size_t)m * LDZ + n] = f2bf(o); }
        else if (p.mode == MODE_BRA) { p.tmp[(size_t)m * D + n] = bf2f(p.Z[(size_t)m * LDZ + ZC_GA + n]) * v; }
        else if (p.mode == MODE_BRB) { p.Z[(size_t)m * LDZ + ZC_ZV + n] = f2bf(p.tmp[(size_t)m * D + n] + bf2f(p.Z[(size_t)m * LDZ + ZC_GB + n]) * v); }
        else if (p.mode == MODE_OUT) { p.out[(size_t)m * D + n] = p.x[(size_t)m * D + n] + p.mod[bb * 6144 + 2048 + n] * v; }
        else { p.out[(size_t)m * D + n] = p.out[(size_t)m * D + n] + p.mod[bb * 6144 + 5120 + n] * v; }
    }
}
__global__ void __launch_bounds__(256) k_up(const bf16_t* __restrict__ A, int lda, const bf16_t* __restrict__ Bt, const float* __restrict__ cw, const float* __restrict__ cb, bf16_t* __restrict__ Gd, int ldg) {
    __shared__ float As[66][33], Bs[64][33];
    const int tid = threadIdx.x, tx = tid & 15, ty = tid >> 4, m0 = blockIdx.y * 64, j0 = blockIdx.x * 32;
    const int t0 = m0 % SEQ;
    float acc[6][4] = {};
    for (int k0 = 0; k0 < D; k0 += 32) {
        for (int e = tid; e < 66 * 32; e += 256) { const int r = e >> 5, k = e & 31; const int tok = t0 - 2 + r;
            As[r][k] = (tok >= 0) ? bf2f(A[(size_t)(m0 - 2 + r) * lda + k0 + k]) : 0.f; }
        for (int e = tid; e < 64 * 32; e += 256) { const int c = e >> 5, k = e & 31; const int col = (c < 32) ? (j0 + c) : (DFF + j0 + c - 32);
            Bs[c][k] = bf2f(Bt[(size_t)col * D + k0 + k]); }
        __syncthreads();
        for (int k = 0; k < 32; ++k) { float a[6], b[4];
            for (int i = 0; i < 6; ++i) a[i] = As[ty * 4 + i][k];
            b[0] = Bs[2 * tx][k]; b[1] = Bs[2 * tx + 1][k]; b[2] = Bs[32 + 2 * tx][k]; b[3] = Bs[32 + 2 * tx + 1][k];
            for (int i = 0; i < 6; ++i) for (int j = 0; j < 4; ++j) acc[i][j] += a[i] * b[j]; }
        __syncthreads();
    }
    for (int i = 0; i < 4; ++i) for (int jj = 0; jj < 2; ++jj) {
        const int j = j0 + 2 * tx + jj, m = m0 + ty * 4 + i;
        const float ua = cb[j] + cw[0 * NUP + j] * acc[i][jj] + cw[1 * NUP + j] * acc[i + 1][jj] + cw[2 * NUP + j] * acc[i + 2][jj];
        const int jv = DFF + j;
        const float uv = cb[jv] + cw[0 * NUP + jv] * acc[i][2 + jj] + cw[1 * NUP + jv] * acc[i + 1][2 + jj] + cw[2 * NUP + jv] * acc[i + 2][2 + jj];
        Gd[(size_t)m * ldg + j] = f2bf(gelu_t(ua) * uv);
    }
}
__global__ void __launch_bounds__(256) k_rnn(bf16_t* __restrict__ Z, const float* __restrict__ cw, const float* __restrict__ cb, const float* __restrict__ wa, const float* __restrict__ ba,
                                             const float* __restrict__ wx, const float* __restrict__ bx, const float* __restrict__ lam) {
    __shared__ float xc[128]; __shared__ float gi[128];
    const int bb = blockIdx.x >> 3, hd = blockIdx.x & 7, tid = threadIdx.x, j = tid & 127, ch = hd * 128 + j; const bool isx = tid >= 128;
    float w[128];
    const float* wsrc = (isx ? wx : wa) + (size_t)hd * 128 * 128;
#pragma unroll
    for (int i = 0; i < 128; ++i) w[i] = wsrc[i * 128 + j];
    const float bias = isx ? bx[ch] : ba[ch];
    const float lsl = -log1pf(expf(-lam[ch]));
    const float c0 = cw[0 * D + ch], c1 = cw[1 * D + ch], c2 = cw[2 * D + ch], c3 = cw[3 * D + ch], cbias = cb[ch];
    float x3 = 0.f, x2 = 0.f, x1 = 0.f, h = 0.f;
    for (int t = 0; t < SEQ; ++t) {
        const size_t m = (size_t)bb * SEQ + t;
        float xcv = 0.f;
        if (!isx) { const float x0 = bf2f(Z[m * LDZ + ZC_XR + ch]); xcv = cbias + c0 * x3 + c1 * x2 + c2 * x1 + c3 * x0; x3 = x2; x2 = x1; x1 = x0; xc[j] = xcv; }
        __syncthreads();
        float acc = bias;
#pragma unroll
        for (int i = 0; i < 128; ++i) acc += xc[i] * w[i];
        const float gate = sigm(acc);
        if (isx) gi[j] = gate;
        __syncthreads();
        if (!isx) { const float la = 8.f * gate * lsl; const float a = expf(la); const float mult = sqrtf(-expm1f(2.f * la)); const float u = mult * (gi[j] * xcv);
            h = a * h + u; Z[m * LDZ + ZC_GR + ch] = f2bf(h * bf2f(Z[m * LDZ + ZC_GR + ch])); }
    }
}
__global__ void k_lnstat(const bf16_t* __restrict__ Z, float* __restrict__ st) {
    __shared__ float r1[256], r2[256];
    const int m = blockIdx.x, tid = threadIdx.x; float v[4], s = 0.f;
    for (int i = 0; i < 4; ++i) { v[i] = bf2f(Z[(size_t)m * LDZ + ZC_ZV + tid + 256 * i]); s += v[i]; }
    r1[tid] = s; __syncthreads();
    for (int o = 128; o > 0; o >>= 1) { if (tid < o) r1[tid] += r1[tid + o]; __syncthreads(); }
    const float mean = r1[0] * (1.f / D); float q = 0.f;
    for (int i = 0; i < 4; ++i) { const float d = v[i] - mean; q += d * d; }
    r2[tid] = q; __syncthreads();
    for (int o = 128; o > 0; o >>= 1) { if (tid < o) r2[tid] += r2[tid + o]; __syncthreads(); }
    if (tid == 0) { st[2 * m] = mean; st[2 * m + 1] = rsqrtf(r2[0] * (1.f / D) + 1e-6f); }
}
__global__ void __launch_bounds__(256) k_sgu(bf16_t* __restrict__ Z, const float* __restrict__ st, const float* __restrict__ lg, const float* __restrict__ lb, const float* __restrict__ ws_, const float* __restrict__ bs) {
    __shared__ float vn[128][128];
    const int nb = blockIdx.x, g = blockIdx.y, tid = threadIdx.x, d = tid & 127, ch = g * 128 + d; const size_t mb = (size_t)nb * 128;
    for (int s = tid >> 7; s < 128; s += 2) { const size_t m = mb + s; vn[s][d] = (bf2f(Z[m * LDZ + ZC_ZV + ch]) - st[2 * m]) * st[2 * m + 1] * lg[ch] + lb[ch]; }
    __syncthreads();
    for (int t = tid >> 7; t < 128; t += 2) { float acc = 0.f; const float* wr = ws_ + ((size_t)g * 128 + t) * 128;
        for (int s = 0; s <= t; ++s) acc += wr[s] * vn[s][d];
        const size_t m = mb + t; Z[m * LDZ + ZC_ZU + ch] = f2bf(bf2f(Z[m * LDZ + ZC_ZU + ch]) * (acc + bs[g * 128 + t])); }
}

extern "C" void kernel_launch(void* const* d_in, const int* in_sizes, int n_in, void* d_out, int out_size, void* d_ws, size_t ws_size, hipStream_t stream) {
    static int grid = 0;
    if (grid == 0) {
        if (n_in != 26 || in_sizes[0] != M * D || out_size != M * D || ws_size < WS_END) { fprintf(stderr, "kernel_launch: unexpected shapes (n_in %d, ws %zu)\n", n_in, ws_size); grid = -1; return; }
        int dev = 0, cus = 0, per_cu = 0;
        if (hipGetDevice(&dev) != hipSuccess || hipDeviceGetAttribute(&cus, hipDeviceAttributeMultiprocessorCount, dev) != hipSuccess) { grid = -1; return; }
        if (hipFuncSetAttribute((const void*)mega, hipFuncAttributeMaxDynamicSharedMemorySize, LDS_BYTES) != hipSuccess) { fprintf(stderr, "kernel_launch: hipFuncSetAttribute failed\n"); grid = -1; return; }
        if (hipOccupancyMaxActiveBlocksPerMultiprocessor(&per_cu, (const void*)mega, NWAVES * 64, LDS_BYTES) != hipSuccess || per_cu < 1) { fprintf(stderr, "kernel_launch: occupancy query says %d\n", per_cu); per_cu = 1; }
        (void)hipGetLastError();
        grid = cus;
    }
    if (grid < 0) return;
    const float* x = (const float*)d_in[0];
    const float* rcw = (const float*)d_in[6]; const float* rcb = (const float*)d_in[7];
    const float* lwa = (const float*)d_in[8]; const float* lba = (const float*)d_in[9]; const float* lwx = (const float*)d_in[10]; const float* lbx = (const float*)d_in[11];
    const float* lam = (const float*)d_in[12]; const float* slg = (const float*)d_in[13]; const float* slb = (const float*)d_in[14]; const float* sws = (const float*)d_in[15];
    const float* sbs = (const float*)d_in[16];
    const float* g_ffn = (const float*)d_in[20]; const float* fcw = (const float*)d_in[22]; const float* fcb = (const float*)d_in[23]; const float* g_fin = (const float*)d_in[25];
    unsigned char* ws = (unsigned char*)d_ws; float* out = (float*)d_out;
    float* mod = (float*)(ws + WS_MOD); float* stat2 = (float*)(ws + WS_STAT2);
    bf16_t* Wup = (bf16_t*)(ws + WS_WUP); bf16_t* Wdn = (bf16_t*)(ws + WS_WDN); bf16_t* Wab = (bf16_t*)(ws + WS_WAB); bf16_t* Wo = (bf16_t*)(ws + WS_WO); bf16_t* Z = (bf16_t*)(ws + WS_Z);
    (void)hipMemsetAsync(ws + WS_CTL, 0, CTL_ZERO_BYTES, stream);
    Args a{};
    for (int i = 0; i < 26; ++i) a.in[i] = (const float*)d_in[i];
    a.out = out; a.ws = ws; a.ph_lo = 0; a.ph_hi = PH_END; a.li = 0;
    hipLaunchKernelGGL(mega, dim3(grid), dim3(NWAVES * 64), LDS_BYTES, stream, a);
}
```
